# Optimizing an MI355X kernel written in HIP

```python
import math
import jax, jax.numpy as jnp
from jax import lax
import numpy as np

D_MODEL = 2048
BATCH = 4
SEQ = 2048
DEPTH = 1
DEC_BATCH = 128
DEC_SEQ = 8
PAST_LEN = 16384
PAGE_SIZE = 128

MIX_WIDTH = 2 * D_MODEL
C_A = MIX_WIDTH // 2
C_B = MIX_WIDTH - C_A
CHUNK = 128
N_HEADS_A = 8
HEAD_DIM_A = C_A // N_HEADS_A
GROUP_B = 16
N_GROUPS_B = C_B // GROUP_B
STATE_P = 64
IN_WIDTH = 3 * C_A + 2 * C_B
EPS = 1e-6
DT_MIN = 1e-3
DT_MAX = 1e-1

kernel_name = "hymba_gmlp_s5_decode_step"


def rmsnorm(x, g):
    xf = x.astype(jnp.float32)
    return xf * lax.rsqrt(jnp.mean(xf * xf, axis=-1, keepdims=True) + EPS) * g.astype(jnp.float32)


def chunk_spatial_mix(v, w_s, b_s):
    bsz, seqlen, nh, dh = v.shape
    pad = (-seqlen) % CHUNK
    vp = jnp.pad(v, ((0, 0), (0, pad), (0, 0), (0, 0)))
    n_chunks = (seqlen + pad) // CHUNK
    vp = vp.reshape(bsz, n_chunks, CHUNK, nh, dh)
    mask = jnp.tril(jnp.ones((CHUNK, CHUNK), jnp.float32))
    w = w_s.astype(jnp.float32) * mask[None]
    out = jnp.einsum('hts,bnshd->bnthd', w, vp) + b_s.astype(jnp.float32).T[None, None, :, :, None]
    return out.reshape(bsz, n_chunks * CHUNK, nh, dh)[:, :seqlen]


def ssm_combine(left, right):
    a1, b1 = left
    a2, b2 = right
    return a1 * a2, a2 * b1 + b2


def s5_branch(xb, h0, a_re, a_im, log_dt, b_re, b_im, c_re, c_im, d_skip):
    bsz, seqlen, _ = xb.shape
    lam = lax.complex(a_re.astype(jnp.float32), a_im.astype(jnp.float32))
    dt = jnp.exp(log_dt.astype(jnp.float32))[:, None]
    lam_bar = jnp.exp(lam * dt)
    b_c = lax.complex(b_re.astype(jnp.float32), b_im.astype(jnp.float32))
    b_bar = ((lam_bar - 1.0) / lam)[:, :, None] * b_c
    u = xb.reshape(bsz, seqlen, N_GROUPS_B, GROUP_B)
    bu = jnp.einsum('gpc,blgc->blgp', b_bar, u.astype(jnp.complex64))
    bu = bu.at[:, 0].add(lam_bar[None] * h0)
    a = jnp.broadcast_to(lam_bar, bu.shape)
    _, h = lax.associative_scan(ssm_combine, (a, bu), axis=1)
    c_c = lax.complex(c_re.astype(jnp.float32), c_im.astype(jnp.float32))
    y = jnp.einsum('gcp,blgp->blgc', c_c, h).real + d_skip.astype(jnp.float32).reshape(N_GROUPS_B, GROUP_B) * u
    return y.reshape(bsz, seqlen, C_B), h[:, -1]


def hybrid_layer(x, h0, g_norm, w_in, g_v, w_s, b_s, a_re, a_im, log_dt,
                 b_re, b_im, c_re, c_im, d_skip, w_glu, b_glu, w_out):
    bsz, seqlen, _ = x.shape
    xn = rmsnorm(x, g_norm)
    z = xn @ w_in.astype(jnp.float32)
    u, v, gate_a, xb, gate_b = jnp.split(z, [C_A, 2 * C_A, 3 * C_A, 3 * C_A + C_B], axis=-1)
    u = jax.nn.gelu(u)
    v = jax.nn.gelu(v).reshape(bsz, seqlen, N_HEADS_A, HEAD_DIM_A)
    v = rmsnorm(v, g_v.reshape(N_HEADS_A, HEAD_DIM_A))
    mixed = chunk_spatial_mix(v, w_s, b_s).reshape(bsz, seqlen, C_A)
    out_a = u * mixed * jax.nn.silu(gate_a)
    y_b, h_last = s5_branch(xb, h0, a_re, a_im, log_dt, b_re, b_im, c_re, c_im, d_skip)
    y_b = jax.nn.gelu(y_b)
    y_b = y_b * jax.nn.sigmoid(y_b @ w_glu.astype(jnp.float32) + b_glu.astype(jnp.float32))
    out_b = y_b * jax.nn.silu(gate_b)
    mix = jnp.concatenate([out_a, out_b], axis=-1)
    x_new = x + mix @ w_out.astype(jnp.float32)
    return x_new, h_last, v.reshape(bsz, seqlen, C_A)


def setup_inputs(seed: int = 0) -> dict:
    key = jax.random.key(seed)
    ks = jax.random.split(key, 24)
    f32 = jnp.float32
    nrm = lambda k, shape, s: jax.random.normal(k, shape, f32) * s
    x_prompt = nrm(ks[0], (BATCH, SEQ, D_MODEL), 1.0)
    x_sample = nrm(ks[1], (DEC_BATCH, DEC_SEQ, D_MODEL), 1.0)
    state_ssm_re = nrm(ks[2], (DEPTH, DEC_BATCH, N_GROUPS_B, STATE_P), 0.3)
    state_ssm_im = nrm(ks[3], (DEPTH, DEC_BATCH, N_GROUPS_B, STATE_P), 0.3)
    g_norm = 1.0 + nrm(ks[4], (DEPTH, D_MODEL), 0.02)
    w_in = nrm(ks[5], (DEPTH, D_MODEL, IN_WIDTH), D_MODEL ** -0.5)
    g_v = 1.0 + nrm(ks[6], (DEPTH, C_A), 0.02)
    w_s = nrm(ks[7], (DEPTH, N_HEADS_A, CHUNK, CHUNK), CHUNK ** -0.5)
    b_s = 1.0 + nrm(ks[8], (DEPTH, N_HEADS_A, CHUNK), 0.02)
    n_idx = jnp.arange(STATE_P, dtype=f32)
    a_re = -0.5 + nrm(ks[9], (DEPTH, N_GROUPS_B, STATE_P), 0.01)
    a_im = math.pi * n_idx[None, None, :] + nrm(ks[10], (DEPTH, N_GROUPS_B, STATE_P), 0.01)
    log_dt = jax.random.uniform(ks[11], (DEPTH, N_GROUPS_B), f32, math.log(DT_MIN), math.log(DT_MAX))
    b_re = nrm(ks[12], (DEPTH, N_GROUPS_B, STATE_P, GROUP_B), (2.0 * GROUP_B) ** -0.5)
    b_im = nrm(ks[13], (DEPTH, N_GROUPS_B, STATE_P, GROUP_B), (2.0 * GROUP_B) ** -0.5)
    c_re = nrm(ks[14], (DEPTH, N_GROUPS_B, GROUP_B, STATE_P), (2.0 * STATE_P) ** -0.5)
    c_im = nrm(ks[15], (DEPTH, N_GROUPS_B, GROUP_B, STATE_P), (2.0 * STATE_P) ** -0.5)
    d_skip = nrm(ks[16], (DEPTH, C_B), 1.0)
    w_glu = nrm(ks[17], (DEPTH, C_B, C_B), C_B ** -0.5)
    b_glu = nrm(ks[18], (DEPTH, C_B), 0.01)
    w_out = nrm(ks[19], (DEPTH, MIX_WIDTH, D_MODEL), MIX_WIDTH ** -0.5)
    g_final = 1.0 + nrm(ks[20], (D_MODEL,), 0.02)
    return {"x_prompt": x_prompt, "x_sample": x_sample,
            "state_ssm_re": state_ssm_re, "state_ssm_im": state_ssm_im,
            "g_norm": g_norm, "w_in": w_in, "g_v": g_v, "w_s": w_s, "b_s": b_s,
            "a_re": a_re, "a_im": a_im, "log_dt": log_dt,
            "b_re": b_re, "b_im": b_im, "c_re": c_re, "c_im": c_im, "d_skip": d_skip,
            "w_glu": w_glu, "b_glu": b_glu, "w_out": w_out, "g_final": g_final}


def reference(x_prompt, x_sample, state_ssm_re, state_ssm_im, g_norm, w_in, g_v, w_s, b_s,
              a_re, a_im, log_dt, b_re, b_im, c_re, c_im, d_skip, w_glu, b_glu, w_out, g_final):
    hp = x_prompt.astype(jnp.float32)
    hs = x_sample.astype(jnp.float32)
    re_p, im_p, re_s, im_s, v_s = [], [], [], [], []
    for l in range(DEPTH):
        params = (g_norm[l], w_in[l], g_v[l], w_s[l], b_s[l], a_re[l], a_im[l], log_dt[l],
                  b_re[l], b_im[l], c_re[l], c_im[l], d_skip[l], w_glu[l], b_glu[l], w_out[l])
        h0_p = jnp.zeros((hp.shape[0], N_GROUPS_B, STATE_P), jnp.complex64)
        h0_s = lax.complex(state_ssm_re[l].astype(jnp.float32), state_ssm_im[l].astype(jnp.float32))
        hp, hl_p, _ = hybrid_layer(hp, h0_p, *params)
        hs, hl_s, vrows_s = hybrid_layer(hs, h0_s, *params)
        re_p.append(hl_p.real)
        im_p.append(hl_p.imag)
        re_s.append(hl_s.real)
        im_s.append(hl_s.imag)
        v_s.append(vrows_s)
    y_prompt = rmsnorm(hp, g_final).astype(x_prompt.dtype)
    y_sample = rmsnorm(hs, g_final).astype(x_sample.dtype)
    new_ssm_re_prompt = jnp.stack(re_p).astype(x_prompt.dtype)
    new_ssm_im_prompt = jnp.stack(im_p).astype(x_prompt.dtype)
    new_ssm_re_sample = jnp.stack(re_s).astype(x_sample.dtype)
    new_ssm_im_sample = jnp.stack(im_s).astype(x_sample.dtype)
    new_chunk_v_sample = jnp.stack(v_s).astype(x_sample.dtype)
    return (y_prompt, y_sample, new_ssm_re_prompt, new_ssm_im_prompt,
            new_ssm_re_sample, new_ssm_im_sample, new_chunk_v_sample)
```

```cpp
#include <hip/hip_runtime.h>
#include <hip/hip_cooperative_groups.h>
#include <cstdio>
namespace cg = cooperative_groups;

namespace pg8 {
#define PG8_LAS __attribute__((address_space(3)))
typedef unsigned short bf16_t;
typedef short bf16x8 __attribute__((ext_vector_type(8)));
typedef float f32x4 __attribute__((ext_vector_type(4)));
typedef unsigned u32x4 __attribute__((ext_vector_type(4)));
constexpr int BM = 256, BK = 64, HALF = 128, HTB = HALF * BK * 2  , STAGE_BYTES = 8 * HTB, NXCD = 8, WGM = 8;

__host__ __device__ __forceinline__ int lds_byte(int r, int c) { const int st = (r >> 4) * 2 + (c >> 5), rr = r & 15, cc = c & 31, ob = rr * 64 + cc * 2; return st * 1024 + (ob ^ (((ob >> 9) & 1) << 5)); }
__host__ __device__ __forceinline__ void stage_rc(int b, int& R, int& C) { const int st = b / 1024, sb = b % 1024, swz = sb ^ (((sb >> 9) & 1) << 5); R = (st >> 1) * 16 + swz / 64; C = (st & 1) * 32 + (swz % 64) / 2; }
__host__ __device__ __forceinline__ int perm32(int rho) { const int n = rho >> 4, i = rho & 15; return 8 * (i >> 2) + 4 * n + (i & 3); }

struct Unit { int pm, pn, k0, nkt; };
struct Gemm { const bf16_t* A; const bf16_t* Bt; int M, N, K; };

struct StaticOrder {
    int nM, nN, nwg, G, c, nkt, nsplit; unsigned* cnt = nullptr;
    __host__ __device__ void init(int M, int N, int K, int G_, int c_, int nsplit_ = 1) { nM = M / BM; nN = N / BM; nwg = nM * nN; G = G_; c = c_; nkt = K / BK;
        nsplit = ((nwg % G) * nsplit_ == G && (nkt / nsplit_) >= 4 && (nkt % (2 * nsplit_)) == 0) ? nsplit_ : 1; }
    __host__ __device__ bool split_active() const { return nsplit > 1; }
    __host__ __device__ void map(int wgid, Unit& u) const {
        { const int q = nwg / NXCD, r = nwg % NXCD, xcd = wgid % NXCD, off = wgid / NXCD; wgid = (xcd < r ? xcd * (q + 1) : r * (q + 1) + (xcd - r) * q) + off; }
        const int nig = WGM * nN, gid = wgid / nig, fm = gid * WGM, gsz = (nM - fm) < WGM ? (nM - fm) : WGM;
        u.pm = fm + ((wgid % nig) % gsz); u.pn = (wgid % nig) / gsz; u.k0 = 0; u.nkt = nkt; }
    __host__ __device__ bool next(int i, Unit& u) const {
        const int full = nwg / G;
        if (nsplit > 1) {
            if (i < full) { map(i * G + c, u); return true; }
            if (i > full) { map(0, u); return false; }
            map(full * G + c / nsplit, u); u.nkt = nkt / nsplit; u.k0 = (c % nsplit) * u.nkt * BK; return true; }
        const long L = (long)i * G + c; if (L >= nwg) { map(0, u); return false; }
        map((int)L, u); return true;
    }
    __device__ __forceinline__ void a_ready(const Unit&) const {}
    __device__ __forceinline__ void done(const Unit& u) const {
        if (cnt != nullptr && u.nkt != nkt) { asm volatile("s_waitcnt vmcnt(0)" ::: "memory");
            if ((threadIdx.x & 63) == 0) __hip_atomic_fetch_add(cnt, 1u, __ATOMIC_RELAXED, __HIP_MEMORY_SCOPE_AGENT); } }
};
__device__ __forceinline__ unsigned cvt_pk_bf16(float lo, float hi) { unsigned r; asm("v_cvt_pk_bf16_f32 %0, %1, %2" : "=v"(r) : "v"(lo), "v"(hi)); return r; }
typedef float f32x2 __attribute__((ext_vector_type(2)));
template <class Epi, class Sched>
__device__ __forceinline__ void gemm_phase(PG8_LAS unsigned char* lds, const Gemm g, const Sched& S, const Epi& E) {
    const int tid = threadIdx.x, wid = __builtin_amdgcn_readfirstlane(tid >> 6), lane = tid & 63, wr = wid >> 2, wc = wid & 3, fr = lane & 15, fq = lane >> 4;
    const int K = g.K;
    unsigned voffA[2], voffB[2];
#pragma unroll
    for (int i = 0; i < 2; ++i) { int R, C; stage_rc(tid * 16 + i * 8192, R, C); const int Rb = Epi::PERM ? ((R & ~31) + perm32(R & 31)) : R;
        voffA[i] = (unsigned)(R * K + C) * 2u; voffB[i] = (unsigned)(Rb * K + C) * 2u; }
    const size_t kstep = (size_t)(BK * 2);
    const size_t hstep = (size_t)HALF * K * 2;
    const size_t tstep = 2 * hstep;
    const unsigned ldsw = (unsigned)wid * 1024u;
    const int aoff = lds_byte(wr * 64 + fr, fq * 8), boff = lds_byte(wc * 32 + fr, fq * 8);
#define PG8_SA(b, h) (((b) * 2 + (h)) * HTB)
#define PG8_SB(b, h) ((4 + (b) * 2 + (h)) * HTB)
#define PG8_STAGE(bufoff, gbase, voff) do { _Pragma("unroll") for (int _i = 0; _i < 2; ++_i) \
        __builtin_amdgcn_global_load_lds((const unsigned*)((const char*)(gbase) + (voff)[_i]), (PG8_LAS unsigned*)(lds + (bufoff) + ldsw + _i * 8192), 16, 0, 0); } while (0)
#define PG8_LDA(dst, b, h) do { _Pragma("unroll") for (int m = 0; m < 4; ++m) _Pragma("unroll") for (int k = 0; k < 2; ++k) dst[m][k] = *(const PG8_LAS bf16x8*)(lds + PG8_SA(b, h) + aoff + m * 2048 + k * 1024); } while (0)
#define PG8_LDB(dst, b, h) do { _Pragma("unroll") for (int n = 0; n < 2; ++n) _Pragma("unroll") for (int k = 0; k < 2; ++k) dst[n][k] = *(const PG8_LAS bf16x8*)(lds + PG8_SB(b, h) + boff + n * 2048 + k * 1024); } while (0)
#define PG8_MMA(ai, bj, At, Bt) do { __builtin_amdgcn_s_setprio(1); _Pragma("unroll") for (int m = 0; m < 4; ++m) _Pragma("unroll") for (int n = 0; n < 2; ++n) _Pragma("unroll") for (int k = 0; k < 2; ++k) \
        acc[ai][bj][m][n] = __builtin_amdgcn_mfma_f32_16x16x32_bf16(Bt[n][k], At[m][k], acc[ai][bj][m][n], 0, 0, 0); __builtin_amdgcn_s_setprio(0); } while (0)
#define PG8_WAIT_V(n) asm volatile("s_waitcnt vmcnt(" #n ")" ::: "memory")
#define PG8_WAIT_L(n) asm volatile("s_waitcnt lgkmcnt(" #n ")" ::: "memory")
#define PG8_BAR __builtin_amdgcn_s_barrier()
#define PG8_SCHED __builtin_amdgcn_sched_barrier(0)
    Unit cur, nxt; int ui = 0;
    if (!S.next(0, cur)) return;
    f32x4 acc[2][2][4][2];
#pragma unroll
    for (int a = 0; a < 2; ++a)
#pragma unroll
        for (int b = 0; b < 2; ++b)
#pragma unroll
            for (int m = 0; m < 4; ++m)
#pragma unroll
                for (int n = 0; n < 2; ++n) acc[a][b][m][n] = (f32x4){0.f, 0.f, 0.f, 0.f};
    bf16x8 At[4][2], B0[2][2], B1[2][2];
    const char* cA = (const char*)g.A + (size_t)cur.pm * tstep + (size_t)cur.k0 * 2; const char* cB = (const char*)g.Bt + (size_t)cur.pn * tstep + (size_t)cur.k0 * 2;
    S.a_ready(cur);
    PG8_STAGE(PG8_SB(0, 0), cB, voffB); PG8_STAGE(PG8_SA(0, 0), cA, voffA); PG8_STAGE(PG8_SB(0, 1), cB + hstep, voffB); PG8_STAGE(PG8_SA(0, 1), cA + hstep, voffA);
    if (wr == 1) PG8_BAR;
    PG8_WAIT_V(4); PG8_BAR;
    PG8_STAGE(PG8_SB(1, 0), cB + kstep, voffB); PG8_STAGE(PG8_SA(1, 0), cA + kstep, voffA); PG8_STAGE(PG8_SB(1, 1), cB + hstep + kstep, voffB);
    PG8_WAIT_V(6); PG8_BAR;
    for (;;) {
        const bool has_next = S.next(ui + 1, nxt);
        const char* nA = has_next ? (const char*)g.A + (size_t)nxt.pm * tstep + (size_t)nxt.k0 * 2 : cA; const char* nB = has_next ? (const char*)g.Bt + (size_t)nxt.pn * tstep + (size_t)nxt.k0 * 2 : cB;
        const int nt = cur.nkt;
        for (int t = 0; t < nt; t += 2) {
            const bool last = (t == nt - 2);
            const char* a1 = cA + (size_t)(t + 1) * kstep;
            const char* a2 = last ? nA : cA + (size_t)(t + 2) * kstep; const char* b2 = last ? nB : cB + (size_t)(t + 2) * kstep;
            const char* a3 = a2 + kstep; const char* b3 = b2 + kstep;
            if (last && has_next) S.a_ready(nxt);
            PG8_LDB(B0, 0, 0); PG8_SCHED; PG8_LDA(At, 0, 0); PG8_STAGE(PG8_SA(1, 1), a1 + hstep, voffA);
            PG8_WAIT_L(8); PG8_BAR; PG8_WAIT_L(0); PG8_MMA(0, 0, At, B0); PG8_BAR; PG8_SCHED;
            PG8_LDB(B1, 0, 1); PG8_STAGE(PG8_SB(0, 0), b2, voffB);
            PG8_BAR; PG8_WAIT_L(0); PG8_MMA(0, 1, At, B1); PG8_BAR;
            PG8_LDA(At, 0, 1); PG8_STAGE(PG8_SA(0, 0), a2, voffA);
            PG8_BAR; PG8_WAIT_L(0); PG8_MMA(1, 0, At, B0); PG8_BAR; PG8_SCHED;
            PG8_STAGE(PG8_SB(0, 1), b2 + hstep, voffB);
            PG8_WAIT_V(6); PG8_BAR; PG8_MMA(1, 1, At, B1); PG8_BAR;
            PG8_LDB(B0, 1, 0); PG8_SCHED; PG8_LDA(At, 1, 0); PG8_STAGE(PG8_SA(0, 1), a2 + hstep, voffA);
            PG8_WAIT_L(8); PG8_BAR; PG8_WAIT_L(0); PG8_MMA(0, 0, At, B0); PG8_BAR; PG8_SCHED;
            PG8_LDB(B1, 1, 1); PG8_STAGE(PG8_SB(1, 0), b3, voffB);
            PG8_BAR; PG8_WAIT_L(0); PG8_MMA(0, 1, At, B1); PG8_BAR;
            PG8_LDA(At, 1, 1); PG8_STAGE(PG8_SA(1, 0), a3, voffA);
            PG8_BAR; PG8_WAIT_L(0); PG8_MMA(1, 0, At, B0); PG8_BAR; PG8_SCHED;
            PG8_STAGE(PG8_SB(1, 1), b3 + hstep, voffB);
            PG8_WAIT_V(6); PG8_BAR; PG8_MMA(1, 1, At, B1); PG8_BAR;
        }
        if (!Epi::AFTER_DRAIN || has_next) { E(acc, cur, wr, wc, fr, fq); S.done(cur); }
        if (!has_next) break;
#pragma unroll
        for (int a = 0; a < 2; ++a)
#pragma unroll
            for (int b = 0; b < 2; ++b)
#pragma unroll
                for (int m = 0; m < 4; ++m)
#pragma unroll
                    for (int n = 0; n < 2; ++n) acc[a][b][m][n] = (f32x4){0.f, 0.f, 0.f, 0.f};
        cur = nxt; cA = nA; cB = nB; ++ui;
    }
    PG8_WAIT_V(0);
    if (wr == 0) PG8_BAR;
    PG8_BAR;
    if constexpr (Epi::AFTER_DRAIN) { E.fused(acc, cur, wr, wc, fr, fq, lds, wid, lane); S.done(cur); }
#undef PG8_SA
#undef PG8_SB
#undef PG8_STAGE
#undef PG8_LDA
#undef PG8_LDB
#undef PG8_MMA
#undef PG8_WAIT_V
#undef PG8_WAIT_L
#undef PG8_BAR
#undef PG8_SCHED
}
}

using pg8::bf16_t; using pg8::bf16x8; using pg8::f32x4; using pg8::u32x4; using pg8::Unit; using pg8::cvt_pk_bf16;
#define LAS __attribute__((address_space(3)))
typedef float f32x16 __attribute__((ext_vector_type(16)));
typedef float f32x2v __attribute__((ext_vector_type(2)));
typedef unsigned u32x2 __attribute__((ext_vector_type(2)));

constexpr int NTOK_P = 8192, NTOK = 9216;
constexpr size_t PLANE = (size_t)NTOK * 2048;
constexpr float EPS = 1e-6f;

constexpr size_t WS_X16 = 0;
constexpr size_t WS_WINT = 37748736;
constexpr size_t WS_MIX = 0;
constexpr size_t WS_WGLU = 79691776;
constexpr size_t WS_WOUT = 88080384;
constexpr size_t WS_Z = 104857600;
constexpr size_t WS_RSCALE = 293601280;
constexpr size_t WS_SSQ = WS_RSCALE + 36864;
constexpr size_t WS_TAB = WS_SSQ;
constexpr size_t WS_CNT2 = WS_SSQ + 16384;
constexpr size_t WS_CNT = WS_SSQ + 4096;
constexpr size_t WS_PART = WS_Z;
constexpr size_t WS_LAM = WS_SSQ + 36864;
constexpr size_t WS_BT = WS_LAM + 65536;
constexpr size_t WS_CT = WS_BT + 524288;
constexpr size_t WS_WS16 = WS_CT + 524288;
constexpr size_t WS_YB = WS_WS16 + 262144;
constexpr size_t WS_EXCH = WS_YB + 37748736;
constexpr size_t WS_BAR = WS_EXCH + 294912;
constexpr size_t WS_END = WS_BAR + 16384;
constexpr int REP0 = 1, REP2 = 1, REP3 = 1;

constexpr size_t O_RE_P = 18874368, O_IM_P = 18907136, O_RE_S = 18939904, O_IM_S = 19988480, O_V = 21037056;

constexpr int S5_ROWB = 528;
constexpr int S5_WAVE_B = 32 * S5_ROWB;
constexpr int LDS_MAIN = 8 * S5_WAVE_B;
constexpr int LDS_BYTES = LDS_MAIN + 16;

struct Params {
    const float *xp, *xs, *sre, *sim, *g_norm, *w_in, *g_v, *w_s, *b_s, *a_re, *a_im, *log_dt, *b_re, *b_im, *c_re, *c_im, *d_skip, *w_glu, *b_glu, *w_out, *g_final;
    float* out; unsigned char* ws;
};

__device__ __forceinline__ float bflo(unsigned w) { return __uint_as_float(w << 16); }
__device__ __forceinline__ float bfhi(unsigned w) { return __uint_as_float(w & 0xffff0000u); }
__device__ __forceinline__ float sigmoid_fast(float t) { return __builtin_amdgcn_rcpf(1.0f + __builtin_amdgcn_exp2f(-1.44269504f * t)); }
__device__ __forceinline__ float gelu_tanh(float x) { return x * sigmoid_fast(x * (1.5957691216f + 0.0713548163f * x * x)); }
__device__ __forceinline__ float silu_f(float x) { return x * sigmoid_fast(x); }
__device__ __forceinline__ f32x2v act_pk(f32x2v x, float c1n, float c3n) {
    const f32x2v q = x * x;
    const f32x2v t = x * (q * c3n + c1n);
    f32x2v e; e.x = __builtin_amdgcn_exp2f(t.x); e.y = __builtin_amdgcn_exp2f(t.y);
    const f32x2v d = e + 1.0f;
    f32x2v r; r.x = __builtin_amdgcn_rcpf(d.x); r.y = __builtin_amdgcn_rcpf(d.y);
    return x * r;
}
__device__ __forceinline__ float wave_sum(float v) {
#pragma unroll
    for (int o = 32; o >= 1; o >>= 1) v += __shfl_xor(v, o);
    return v;
}
#define LGKM0() asm volatile("s_waitcnt lgkmcnt(0)" ::: "memory")
#define WAVE_ORDER() asm volatile("" ::: "memory")


#define XB_TMO      128
#define XB_XCNT(j)  (256  + 64 * (j))
#define XB_XSUB(j)  (1280 + 64 * (j))
#define XB_XGEN(j)  (2304 + 64 * (j))
#define XB_TOP      3328
#define XB_TOPGEN   3392
#define XCD_BAR_WORDS 3456
#define XB_SPIN_CAP (1u << 18)
__device__ __forceinline__ unsigned xb_ld(unsigned* p)              { return __hip_atomic_load(p, __ATOMIC_RELAXED, __HIP_MEMORY_SCOPE_AGENT); }
__device__ __forceinline__ unsigned xb_add(unsigned* p, unsigned v) { return __hip_atomic_fetch_add(p, v, __ATOMIC_RELAXED, __HIP_MEMORY_SCOPE_AGENT); }
__device__ __forceinline__ unsigned xb_xcc_id() { return (unsigned)__builtin_amdgcn_s_getreg((3 << 11) | 20) & 0xFu; }
#define XB_SPIN(cond, bar) do { unsigned _sp = 0; while (cond) { __builtin_amdgcn_s_sleep(1); \
    if ((++_sp & 255u) == 0u) { if (xb_ld(&(bar)[XB_TMO])) break; if (_sp > XB_SPIN_CAP) { atomicAdd(&(bar)[XB_TMO], 1u); break; } } } } while (0)

struct XcdBarrier {
    unsigned* bar; unsigned x;
    volatile LAS unsigned* st;
};

__device__ __forceinline__ XcdBarrier xcd_barrier_post(unsigned* bar, volatile LAS unsigned* st) {
    XcdBarrier b; b.bar = bar; b.x = xb_xcc_id(); b.st = st;
    if (threadIdx.x == 0) (void)xb_add(&bar[XB_XCNT(b.x)], 1u);
    return b;
}
__device__ __forceinline__ void xcd_barrier_complete(unsigned* bar, unsigned x, unsigned& nloc, unsigned& nx) {
    const unsigned G = gridDim.x * gridDim.y * gridDim.z;
    unsigned sum, cnt, mine, sp = 0u;
    for (;;) {
        sum = 0u; cnt = 0u; mine = 0u;
#pragma unroll
        for (unsigned j = 0; j < 16; ++j) { const unsigned c = xb_ld(&bar[XB_XCNT(j)]); sum += c; cnt += (c > 0u) ? 1u : 0u; mine = (j == x) ? c : mine; }
        if (sum == G) break;
        __builtin_amdgcn_s_sleep(1);
        if ((++sp & 255u) == 0u) { if (xb_ld(&bar[XB_TMO])) break; if (sp > XB_SPIN_CAP) { atomicAdd(&bar[XB_TMO], 1u); break; } }
    }
    nloc = mine > 0u ? mine : 1u; nx = cnt > 0u ? cnt : 1u;
}

__device__ __forceinline__ void xcd_barrier(const XcdBarrier& b) {
    asm volatile("s_waitcnt vmcnt(0)" ::: "memory");
    __syncthreads();
    if (threadIdx.x == 0) {
        unsigned* bar = b.bar;
        __builtin_amdgcn_s_waitcnt(0);
        unsigned nloc = b.st[0], nx = b.st[1];
        if (nloc == 0u) { xcd_barrier_complete(bar, b.x, nloc, nx); b.st[0] = nloc; b.st[1] = nx; }
        const unsigned old = xb_add(&bar[XB_XSUB(b.x)], 1u);
        const unsigned gen = old / nloc;
        if (old + 1u == (gen + 1u) * nloc) {
            __builtin_amdgcn_fence(__ATOMIC_RELEASE, "agent");
            asm volatile("s_waitcnt vmcnt(0)" ::: "memory");
            const unsigned og = xb_add(&bar[XB_TOP], 1u);
            const unsigned tg = og / nx;
            if (og + 1u == (tg + 1u) * nx) xb_add(&bar[XB_TOPGEN], 1u);
            else XB_SPIN(xb_ld(&bar[XB_TOPGEN]) == tg, bar);
            __builtin_amdgcn_fence(__ATOMIC_ACQUIRE, "agent");
            xb_add(&bar[XB_XGEN(b.x)], 1u);
            asm volatile("s_waitcnt vmcnt(0)" ::: "memory");
        } else {
            XB_SPIN(xb_ld(&bar[XB_XGEN(b.x)]) == gen, bar);
            __builtin_amdgcn_fence(__ATOMIC_ACQUIRE, "agent");
            asm volatile("s_waitcnt vmcnt(0)" ::: "memory");
        }
    }
    __syncthreads();
}

__device__ __forceinline__ float rsvc(const float (&a)[8], int i) { return a[i]; }
struct EpiInProj {
    static constexpr bool PERM = true, AFTER_DRAIN = false;
    bf16_t* Z; const float* rscale;
    __device__ __forceinline__ void operator()(const f32x4 (&acc)[2][2][4][2], const Unit& u, int wr, int wc, int fr, int fq) const {
        const int row0c = u.pm * 256 + wr * 64 + fr;
        if (u.pn < 16) {
            const int colc = u.pn * 128 + wc * 32 + 8 * fq;
#pragma unroll
            for (int ai = 0; ai < 2; ++ai)
#pragma unroll
                for (int m = 0; m < 4; ++m) {
                    f32x2v pr[4];
#pragma unroll
                    for (int n = 0; n < 2; ++n) { const f32x4 ua = acc[ai][0][m][n], ga = acc[ai][1][m][n];
                        pr[2 * n] = act_pk((f32x2v){ua[0], ua[1]}, -1.44269504f * 1.5957691216f, -1.44269504f * 0.0713548163f) * act_pk((f32x2v){ga[0], ga[1]}, -1.44269504f, 0.0f);
                        pr[2 * n + 1] = act_pk((f32x2v){ua[2], ua[3]}, -1.44269504f * 1.5957691216f, -1.44269504f * 0.0713548163f) * act_pk((f32x2v){ga[2], ga[3]}, -1.44269504f, 0.0f); }
                    u32x4 w; w.x = cvt_pk_bf16(pr[0].x, pr[0].y); w.y = cvt_pk_bf16(pr[1].x, pr[1].y); w.z = cvt_pk_bf16(pr[2].x, pr[2].y); w.w = cvt_pk_bf16(pr[3].x, pr[3].y);
                    *(u32x4*)(Z + (size_t)(row0c + ai * 128 + m * 16) * 2048 + colc) = w;
                }
            return;
        }
        const int sq = (u.pn >> 3) - 2;
        const int sec = (sq == 0) ? 1 : (sq == 1) ? 3 : 4;
        const float c1n = (sec < 2) ? -1.44269504f * 1.5957691216f : -1.44269504f, c3n = (sec < 2) ? -1.44269504f * 0.0713548163f : 0.0f;
        const bool ident = (sec == 3);
        bf16_t* base = Z + (size_t)sec * PLANE;
        const int row0 = u.pm * 256 + wr * 64 + fr, col0 = (u.pn & 7) * 256 + wc * 32 + 8 * fq;
#pragma unroll
        for (int ai = 0; ai < 2; ++ai)
#pragma unroll
            for (int m = 0; m < 4; ++m) {
                const int row = row0 + ai * 128 + m * 16;
                bf16_t* rowp = base + (size_t)row * 2048 + col0;
#pragma unroll
                for (int bj = 0; bj < 2; ++bj) {
                    f32x2v v2[4];
#pragma unroll
                    for (int n = 0; n < 2; ++n) { const f32x4 a4 = acc[ai][bj][m][n]; v2[2 * n] = (f32x2v){a4[0], a4[1]}; v2[2 * n + 1] = (f32x2v){a4[2], a4[3]}; }
                    if (!ident) {
#pragma unroll
                        for (int j = 0; j < 4; ++j) v2[j] = act_pk(v2[j], c1n, c3n);
                    }
                    u32x4 w; w.x = cvt_pk_bf16(v2[0].x, v2[0].y); w.y = cvt_pk_bf16(v2[1].x, v2[1].y); w.z = cvt_pk_bf16(v2[2].x, v2[2].y); w.w = cvt_pk_bf16(v2[3].x, v2[3].y);
                    *(u32x4*)(rowp + bj * 128) = w;
                }
            }
    }
};
struct EpiGlu {
    static constexpr bool PERM = true, AFTER_DRAIN = false;
    const bf16_t* YB; const bf16_t* SGB; const float* bias; bf16_t* MIX; float* part; int tu;
    __device__ __forceinline__ void operator()(const f32x4 (&acc)[2][2][4][2], const Unit& u, int wr, int wc, int fr, int fq) const {
        const int row0 = u.pm * 256 + wr * 64 + fr, col0 = u.pn * 256 + wc * 32 + 8 * fq;
        if (u.nkt != 32) {
            bf16_t* pt = (bf16_t*)part + ((size_t)(u.k0 / (u.nkt * 64)) * 32 + tu) * 65536 + (size_t)((wr * 4 + wc) * 16) * 512 + (fq * 16 + fr) * 8;
#pragma unroll
            for (int ai = 0; ai < 2; ++ai)
#pragma unroll
                for (int m = 0; m < 4; ++m)
#pragma unroll
                    for (int bj = 0; bj < 2; ++bj) {
                        const f32x4 v0 = acc[ai][bj][m][0], v1 = acc[ai][bj][m][1];
                        u32x4 w; w.x = cvt_pk_bf16(v0[0], v0[1]); w.y = cvt_pk_bf16(v0[2], v0[3]); w.z = cvt_pk_bf16(v1[0], v1[1]); w.w = cvt_pk_bf16(v1[2], v1[3]);
                        bf16_t* dst = pt + ((ai * 4 + m) * 2 + bj) * 512;
                        asm volatile("global_store_dwordx4 %0, %1, off sc1\n\ts_nop 2" :: "v"(dst), "v"(w) : "memory");
                    }
            return;
        }
        f32x4 bv[2][2];
#pragma unroll
        for (int bj = 0; bj < 2; ++bj)
#pragma unroll
            for (int n = 0; n < 2; ++n) bv[bj][n] = *(const f32x4*)(bias + col0 + bj * 128 + 4 * n);
#pragma unroll
        for (int ai = 0; ai < 4; ++ai) {
            u32x4 ybv[2][2], gbv[2][2];
#pragma unroll
            for (int m = 0; m < 2; ++m)
#pragma unroll
                for (int bj = 0; bj < 2; ++bj) { const size_t row = (size_t)(row0 + (ai >> 1) * 128 + ((ai & 1) * 2 + m) * 16);
                    ybv[m][bj] = *(const u32x4*)(YB + row * 2048 + col0 + bj * 128); gbv[m][bj] = *(const u32x4*)(SGB + row * 2048 + col0 + bj * 128); }
#pragma unroll
            for (int m = 0; m < 2; ++m) {
                const size_t row = (size_t)(row0 + (ai >> 1) * 128 + ((ai & 1) * 2 + m) * 16);
#pragma unroll
                for (int bj = 0; bj < 2; ++bj) {
                    const u32x4 yb = ybv[m][bj], gb = gbv[m][bj];
                    f32x2v o2[4];
#pragma unroll
                    for (int w = 0; w < 4; ++w) {
                        const f32x4 a4 = acc[ai >> 1][bj][(ai & 1) * 2 + m][w >> 1], b4 = bv[bj][w >> 1];
                        const f32x2v t = ((f32x2v){a4[(w & 1) * 2], a4[(w & 1) * 2 + 1]} + (f32x2v){b4[(w & 1) * 2], b4[(w & 1) * 2 + 1]}) * -1.44269504f;
                        f32x2v e; e.x = __builtin_amdgcn_exp2f(t.x); e.y = __builtin_amdgcn_exp2f(t.y);
                        const f32x2v d = e + 1.0f;
                        f32x2v r; r.x = __builtin_amdgcn_rcpf(d.x); r.y = __builtin_amdgcn_rcpf(d.y);
                        o2[w] = ((f32x2v){bflo(yb[w]), bfhi(yb[w])} * (f32x2v){bflo(gb[w]), bfhi(gb[w])}) * r;
                    }
                    u32x4 wv; wv.x = cvt_pk_bf16(o2[0].x, o2[0].y); wv.y = cvt_pk_bf16(o2[1].x, o2[1].y); wv.z = cvt_pk_bf16(o2[2].x, o2[2].y); wv.w = cvt_pk_bf16(o2[3].x, o2[3].y);
                    *(u32x4*)(MIX + row * 4096 + 2048 + col0 + bj * 128) = wv;
                }
            }
        }
    }
};
struct EpiOut {
    static constexpr bool PERM = false, AFTER_DRAIN = false;
    const float* xp; const float* xs; float* out; float* part; int tu;
    __device__ __forceinline__ void operator()(const f32x4 (&acc)[2][2][4][2], const Unit& u, int wr, int wc, int fr, int fq) const {
        const int row0 = u.pm * 256 + wr * 64 + fr, col0 = u.pn * 256 + wc * 32 + 4 * fq;
        const float* xb = (u.pm < 32) ? xp : xs - (size_t)NTOK_P * 2048;
        const bool split = (u.nkt != 64);
        if (!split) {
#pragma unroll
            for (int a4 = 0; a4 < 4; ++a4) {
                const int ai = a4 >> 1, m0 = (a4 & 1) * 2;
                f32x4 xv[2][2][2];
#pragma unroll
                for (int m = 0; m < 2; ++m)
#pragma unroll
                    for (int bj = 0; bj < 2; ++bj)
#pragma unroll
                        for (int n = 0; n < 2; ++n) xv[m][bj][n] = *(const f32x4*)(xb + (size_t)(row0 + ai * 128 + (m0 + m) * 16) * 2048 + col0 + bj * 128 + n * 16);
#pragma unroll
                for (int m = 0; m < 2; ++m)
#pragma unroll
                    for (int bj = 0; bj < 2; ++bj)
#pragma unroll
                        for (int n = 0; n < 2; ++n) *(f32x4*)(out + (size_t)(row0 + ai * 128 + (m0 + m) * 16) * 2048 + col0 + bj * 128 + n * 16) = xv[m][bj][n] + acc[ai][bj][m0 + m][n];
            }
        } else {
            float* pt = part + ((size_t)(u.k0 / (u.nkt * 64)) * 32 + tu) * 65536 + (size_t)(wr * 64 + fr) * 256 + wc * 32 + 4 * fq;
#pragma unroll
            for (int ai = 0; ai < 2; ++ai)
#pragma unroll
                for (int m = 0; m < 4; ++m)
#pragma unroll
                    for (int bj = 0; bj < 2; ++bj)
#pragma unroll
                        for (int n = 0; n < 2; ++n) *(f32x4*)(pt + (size_t)(ai * 128 + m * 16) * 256 + bj * 128 + n * 16) = acc[ai][bj][m][n];
        }
    }
};

struct OutOrder {
    int c;
    __device__ __forceinline__ bool next(int i, Unit& u) const {
        const int j = c >> 3, x = c & 7; const bool first = (i == 0);
        u.pm = first ? 32 + (j >> 3) : 4 * x + (j >> 3); u.pn = j & 7; u.k0 = first ? x * 512 : 0; u.nkt = first ? 8 : 64;
        return i < 2;
    }
    __device__ __forceinline__ void a_ready(const Unit&) const {}
    __device__ __forceinline__ void done(const Unit&) const {}
};
struct EpiOutF {
    static constexpr bool PERM = false, AFTER_DRAIN = true;
    const float* xp; float* out; const float* gfin; unsigned char* ws;
    __device__ __forceinline__ void operator()(const f32x4 (&acc)[2][2][4][2], const Unit& u, int wr, int wc, int fr, int fq) const {
        const int tu = (u.pm - 32) * 8 + u.pn;
        bf16_t* pt = (bf16_t*)(ws + WS_PART) + ((size_t)(u.k0 / 512) * 32 + tu) * 65536 + (size_t)(wr * 64 + fr) * 256 + wc * 32 + 4 * fq;
#pragma unroll
        for (int ai = 0; ai < 2; ++ai)
#pragma unroll
            for (int m = 0; m < 4; ++m)
#pragma unroll
                for (int bj = 0; bj < 2; ++bj)
#pragma unroll
                    for (int n = 0; n < 2; ++n) { const f32x4 v = acc[ai][bj][m][n]; u32x2 w; w.x = cvt_pk_bf16(v[0], v[1]); w.y = cvt_pk_bf16(v[2], v[3]);
                        *(u32x2*)(pt + (size_t)(ai * 128 + m * 16) * 256 + bj * 128 + n * 16) = w; }
    }
    __device__ __forceinline__ void fused(f32x4 (&acc)[2][2][4][2], const Unit& u, int wr, int wc, int fr, int fq, PG8_LAS unsigned char* lds, int wid, int lane) const {
        PG8_LAS float* P = (PG8_LAS float*)lds;
        float* exch = (float*)(ws + WS_EXCH); unsigned* cnt = (unsigned*)(ws + WS_CNT2);
        PG8_LAS float* Sx = (PG8_LAS float*)(lds + 4096);
        const int row0 = u.pm * 256 + wr * 64 + fr, col0 = u.pn * 256 + wc * 32 + 4 * fq;
#pragma unroll
        for (int a8 = 0; a8 < 8; ++a8) {
            const int ai = a8 >> 2, m = a8 & 3;
            f32x4 xv[2][2];
#pragma unroll
            for (int bj = 0; bj < 2; ++bj)
#pragma unroll
                for (int n = 0; n < 2; ++n) xv[bj][n] = *(const f32x4*)(xp + (size_t)(row0 + ai * 128 + m * 16) * 2048 + col0 + bj * 128 + n * 16);
            float sq = 0.f;
#pragma unroll
            for (int bj = 0; bj < 2; ++bj)
#pragma unroll
                for (int n = 0; n < 2; ++n) { const f32x4 o = xv[bj][n] + acc[ai][bj][m][n]; acc[ai][bj][m][n] = o; sq += (o[0] * o[0] + o[1] * o[1]) + (o[2] * o[2] + o[3] * o[3]); }
            sq += __shfl_xor(sq, 16); sq += __shfl_xor(sq, 32);
            if (fq == 0) P[(ai * 128 + wr * 64 + m * 16 + fr) * 4 + wc] = sq;
        }
        asm volatile("s_waitcnt lgkmcnt(0)" ::: "memory"); __builtin_amdgcn_s_barrier(); asm volatile("" ::: "memory");
        const int tid = wid * 64 + lane;
        if (tid < 256) {
            const float t = (P[tid * 4 + 0] + P[tid * 4 + 1]) + (P[tid * 4 + 2] + P[tid * 4 + 3]);
            __hip_atomic_store(exch + ((size_t)(u.pm * 256 + tid) * 8 + u.pn), t, __ATOMIC_RELAXED, __HIP_MEMORY_SCOPE_AGENT);
            asm volatile("s_waitcnt vmcnt(0)" ::: "memory");
            if (lane == 0) __hip_atomic_fetch_add(cnt + 64 * u.pm, 1u, __ATOMIC_RELAXED, __HIP_MEMORY_SCOPE_AGENT);
        }
        if (wid == 0) {
            unsigned sp = 0;
            while ((unsigned)__builtin_amdgcn_readfirstlane(__hip_atomic_load(cnt + 64 * u.pm, __ATOMIC_RELAXED, __HIP_MEMORY_SCOPE_AGENT)) < 32u) { __builtin_amdgcn_s_sleep(2); if (++sp > (1u << 22)) break; }
            __builtin_amdgcn_fence(__ATOMIC_ACQUIRE, "agent");
        }
        asm volatile("s_waitcnt vmcnt(0) lgkmcnt(0)" ::: "memory"); __builtin_amdgcn_s_barrier(); asm volatile("" ::: "memory");
        if (tid < 256) {
            const float* sl = exch + (size_t)(u.pm * 256 + tid) * 8; float t = 0.f;
#pragma unroll
            for (int q = 0; q < 8; ++q) t += __hip_atomic_load(sl + q, __ATOMIC_RELAXED, __HIP_MEMORY_SCOPE_AGENT);
            Sx[tid] = rsqrtf(t * (1.0f / 2048.0f) + EPS);
        }
        asm volatile("s_waitcnt lgkmcnt(0)" ::: "memory"); __builtin_amdgcn_s_barrier(); asm volatile("" ::: "memory");
        f32x4 gv[2][2];
#pragma unroll
        for (int bj = 0; bj < 2; ++bj)
#pragma unroll
            for (int n = 0; n < 2; ++n) gv[bj][n] = *(const f32x4*)(gfin + col0 + bj * 128 + n * 16);
#pragma unroll
        for (int ai = 0; ai < 2; ++ai)
#pragma unroll
            for (int m = 0; m < 4; ++m) {
                const int rl = ai * 128 + wr * 64 + m * 16 + fr; const float rs = Sx[rl];
#pragma unroll
                for (int bj = 0; bj < 2; ++bj)
#pragma unroll
                    for (int n = 0; n < 2; ++n) __builtin_nontemporal_store(acc[ai][bj][m][n] * rs * gv[bj][n], (f32x4*)(out + (size_t)(u.pm * 256 + rl) * 2048 + col0 + bj * 128 + n * 16));
            }
    }
};

__device__ __forceinline__ void glu_tail_reduce(const Params& p, const pg8::StaticOrder& S, int G) {
    const int tid = threadIdx.x, bid = blockIdx.x, tu = bid / S.nsplit, kc = bid % S.nsplit;
    unsigned* cnt = (unsigned*)(p.ws + WS_CNT) + tu * 64;
    if (tid == 0) {
        unsigned sp = 0;
        while (__hip_atomic_load(cnt, __ATOMIC_RELAXED, __HIP_MEMORY_SCOPE_AGENT) < (unsigned)S.nsplit * 8u) { __builtin_amdgcn_s_sleep(2); if (++sp > (1u << 22)) break; }
        __builtin_amdgcn_fence(__ATOMIC_ACQUIRE, "agent");
        asm volatile("s_waitcnt vmcnt(0)" ::: "memory");
    }
    __syncthreads();
    Unit u; S.map((S.nwg / G) * G + tu, u);
    const bf16_t* part = (const bf16_t*)(p.ws + WS_PART) + (size_t)tu * 65536;
    const bf16_t* YB = (const bf16_t*)(p.ws + WS_YB); const bf16_t* SGB = (const bf16_t*)(p.ws + WS_Z) + 4 * PLANE; bf16_t* MIX = (bf16_t*)(p.ws + WS_MIX);
    const int rl = kc * 32 + (tid >> 4), cl = (tid & 15) * 16;
    const size_t row = (size_t)(u.pm * 256 + rl); const int col = u.pn * 256 + cl;
    f32x4 a[4];
#pragma unroll
    for (int q = 0; q < 4; ++q) a[q] = *(const f32x4*)(p.b_glu + col + 4 * q);
    const int r_ai = rl >> 7, r_wr = (rl >> 6) & 1, r_m = (rl >> 4) & 3, r_fr = rl & 15, r_bj = cl >> 7, r_wc = (cl >> 5) & 3, r_fq0 = (cl >> 3) & 3;
    const size_t lidx = (size_t)((((r_wr * 4 + r_wc) * 2 + r_ai) * 4 + r_m) * 2 + r_bj) * 512 + (r_fq0 * 16 + r_fr) * 8;
#pragma unroll
    for (int c8 = 0; c8 < 8; ++c8)
#pragma unroll
        for (int q = 0; q < 2; ++q) { const u32x4 w = *(const u32x4*)(part + (size_t)c8 * 32 * 65536 + lidx + q * 128);
            a[2 * q] += (f32x4){bflo(w.x), bfhi(w.x), bflo(w.y), bfhi(w.y)}; a[2 * q + 1] += (f32x4){bflo(w.z), bfhi(w.z), bflo(w.w), bfhi(w.w)}; }
    u32x4 yb[2], gb[2], o[2];
#pragma unroll
    for (int q = 0; q < 2; ++q) { yb[q] = *(const u32x4*)(YB + row * 2048 + col + 8 * q); gb[q] = *(const u32x4*)(SGB + row * 2048 + col + 8 * q); }
#pragma unroll
    for (int q = 0; q < 2; ++q)
#pragma unroll
        for (int w = 0; w < 4; ++w) {
            const f32x4 av = a[2 * q + (w >> 1)];
            const float lo = bflo(yb[q][w]) * sigmoid_fast(av[(w & 1) * 2]) * bflo(gb[q][w]), hi = bfhi(yb[q][w]) * sigmoid_fast(av[(w & 1) * 2 + 1]) * bfhi(gb[q][w]);
            o[q][w] = cvt_pk_bf16(lo, hi);
        }
#pragma unroll
    for (int q = 0; q < 2; ++q) *(u32x4*)(MIX + row * 4096 + 2048 + col + 8 * q) = o[q];
}

__device__ __forceinline__ void sincos_d(double x, double& s, double& c) {
    const double q = rint(x * 0.6366197723675814);
    double r = fma(-q, 1.5707963267948966, x); r = fma(-q, 6.123233995736766e-17, r);
    const int qi = (int)q; const double r2 = r * r;
    const double sp = r * (1.0 + r2 * (-1.0 / 6 + r2 * (1.0 / 120 + r2 * (-1.0 / 5040 + r2 * (1.0 / 362880 + r2 * (-1.0 / 39916800 + r2 * (1.0 / 6227020800.0)))))));
    const double cp = 1.0 + r2 * (-0.5 + r2 * (1.0 / 24 + r2 * (-1.0 / 720 + r2 * (1.0 / 40320 + r2 * (-1.0 / 3628800 + r2 * (1.0 / 479001600 + r2 * (-1.0 / 87178291200.0)))))));
    const int k = qi & 3;
    s = (k == 0) ? sp : (k == 1) ? cp : (k == 2) ? -sp : -cp;
    c = (k == 0) ? cp : (k == 1) ? -sp : (k == 2) ? -cp : sp;
}
__device__ __forceinline__ double exp_d(double x) {
    const double k = rint(x * 1.4426950408889634);
    double r = fma(-k, 0.6931471805599453, x); r = fma(-k, 2.3190468138462996e-17, r);
    double p = 1.0 / 479001600;
    p = p * r + 1.0 / 39916800; p = p * r + 1.0 / 3628800; p = p * r + 1.0 / 362880; p = p * r + 1.0 / 40320; p = p * r + 1.0 / 5040; p = p * r + 1.0 / 720;
    p = p * r + 1.0 / 120; p = p * r + 1.0 / 24; p = p * r + 1.0 / 6; p = p * r + 0.5; p = p * r + 1.0; p = p * r + 1.0;
    return __builtin_ldexp(p, (int)k);
}

__device__ __forceinline__ void transpose_tiles(const Params& p, LAS unsigned char* lds, int t0, int t1, int start, int stride) {
    const int tid = threadIdx.x; unsigned char* ws = p.ws;
    LAS float* tile = (LAS float*)lds;
    constexpr int TS = 260;
    f32x4 r[8]; float sc[8];
    auto tile_of = [&](int t, const float*& src, bf16_t*& dst, int& K, int& N, int& kt, int& nt, const float*& gk) {
        int tl; gk = nullptr;
        if (t < 1280) { src = p.w_in; dst = (bf16_t*)(ws + WS_WINT); K = 2048; N = 10240; tl = t; gk = p.g_norm; }
        else if (t < 1536) { src = p.w_glu; dst = (bf16_t*)(ws + WS_WGLU); K = 2048; N = 2048; tl = t - 1280; }
        else { src = p.w_out; dst = (bf16_t*)(ws + WS_WOUT); K = 4096; N = 2048; tl = t - 1536; }
        const int tn = N / 256; kt = tl / tn; nt = tl % tn; };
    auto load_tile = [&](int t) {
        const float* src; bf16_t* dst; int K, N, kt, nt; const float* gk; tile_of(t, src, dst, K, N, kt, nt, gk);
#pragma unroll
        for (int i = 0; i < 8; ++i) { const int k = (tid >> 6) + 8 * i;
            r[i] = __builtin_nontemporal_load((const f32x4*)(src + (size_t)(kt * 64 + k) * N + nt * 256 + (tid & 63) * 4)); sc[i] = gk ? gk[kt * 64 + k] : 1.0f; } };
    int t = t0 + start;
    if (t < t1) load_tile(t);
    for (; t < t1; t += stride) {
        const float* src; bf16_t* dst; int K, N, kt, nt; const float* gk; tile_of(t, src, dst, K, N, kt, nt, gk);
#pragma unroll
        for (int i = 0; i < 8; ++i) { const int k = (tid >> 6) + 8 * i; *(LAS f32x4*)(tile + k * TS + (tid & 63) * 4) = r[i] * sc[i]; }
        __syncthreads();
        if (t + stride < t1) load_tile(t + stride);
        {
            const int n = tid >> 1, kh = (tid & 1) * 32; float v[32];
#pragma unroll
            for (int j = 0; j < 32; ++j) v[j] = tile[(kh + j) * TS + n];
            int nrow = nt * 256 + n;
            if (t < 1280) {
                if (nrow < 2048) nrow = (nrow >> 7) * 256 + (nrow & 127);
                else if (nrow < 4096) nrow += 2048;
                else if (nrow < 6144) { const int c = nrow - 4096; nrow = (c >> 7) * 256 + 128 + (c & 127); }
            }
            bf16_t* dp = dst + (size_t)nrow * K + kt * 64 + kh;
#pragma unroll
            for (int q = 0; q < 4; ++q) { u32x4 w; w.x = cvt_pk_bf16(v[8 * q], v[8 * q + 1]); w.y = cvt_pk_bf16(v[8 * q + 2], v[8 * q + 3]); w.z = cvt_pk_bf16(v[8 * q + 4], v[8 * q + 5]); w.w = cvt_pk_bf16(v[8 * q + 6], v[8 * q + 7]);
                *(u32x4*)(dp + 8 * q) = w; }
        }
        __syncthreads();
    }
}
__device__ __forceinline__ void build_tables(const Params& p, int gt, int GS, int G) {
    unsigned char* ws = p.ws;
    float* lam = (float*)(ws + WS_LAM); bf16_t* Bt = (bf16_t*)(ws + WS_BT); bf16_t* Ct = (bf16_t*)(ws + WS_CT); bf16_t* W16 = (bf16_t*)(ws + WS_WS16);
    for (int idx = gt; idx < 131072; idx += GS) {
        const int c = idx & 15, gp = idx >> 4, g = gp >> 6, pp = gp & 63;
        const double dt = exp_d((double)p.log_dt[g]), are = (double)p.a_re[gp], aim = (double)p.a_im[gp];
        const double mag = exp_d(are * dt); double sn, cs; sincos_d(aim * dt, sn, cs);
        const double lr = mag * cs, li = mag * sn;
        if (c == 0) { lam[gp * 2] = (float)lr; lam[gp * 2 + 1] = (float)li; }
        const double den = are * are + aim * aim, nr = lr - 1.0, ni = li;
        const double fr_ = (nr * are + ni * aim) / den, fi_ = (ni * are - nr * aim) / den;
        const double br = (double)p.b_re[idx], bi = (double)p.b_im[idx];
        const unsigned w = cvt_pk_bf16((float)(fr_ * br - fi_ * bi), (float)(fr_ * bi + fi_ * br));
        Bt[((size_t)g * 128 + 2 * pp) * 16 + c] = (bf16_t)(w & 0xffffu); Bt[((size_t)g * 128 + 2 * pp + 1) * 16 + c] = (bf16_t)(w >> 16);
    }
    for (int idx = gt; idx < 131072; idx += GS) {
        const int pp = idx & 63, gc = idx >> 6;
        *(unsigned*)(Ct + (size_t)gc * 128 + 2 * pp) = cvt_pk_bf16(p.c_re[idx], -p.c_im[idx]);
        const int s_ = idx & 127, tt = (idx >> 7) & 127;
        W16[idx] = (bf16_t)(cvt_pk_bf16(s_ <= tt ? p.w_s[idx] : 0.0f, 0.0f) & 0xffffu);
    }
    if (gt < 288) { pg8::StaticOrder S; S.init(NTOK, 2048, 4096, G, 0, 8); int v = -1;
        if (S.split_active()) { const int base = (S.nwg / G) * G; for (int t = 0; t < S.nwg - base; ++t) { Unit u; S.map(base + t, u); if (u.pm * 8 + u.pn == gt) v = t; } }
        ((int*)(ws + WS_TAB))[gt] = v; }
}
__device__ __forceinline__ int inproj_rem(int G) { return 1440 % G; }

__device__ __forceinline__ void phase0(const Params& p, LAS unsigned char* lds) {
    const int tid = threadIdx.x, G = gridDim.x, bid = blockIdx.x, wid = tid >> 6, lane = tid & 63;
    unsigned char* ws = p.ws;
    if (bid == 0) { for (int i = tid; i < 32 * 64; i += 512) ((unsigned*)(ws + WS_CNT))[i] = 0u; for (int i = tid; i < 36 * 64; i += 512) ((unsigned*)(ws + WS_CNT2))[i] = 0u; }
    transpose_tiles(p, lds, 0, 1280, bid, G);
    {
        bf16_t* X16 = (bf16_t*)(ws + WS_X16); float* rscale = (float*)(ws + WS_RSCALE);
        for (int row = bid * 8 + wid; row < NTOK; row += G * 8) {
            const float* xr = (row < NTOK_P) ? p.xp + (size_t)row * 2048 : p.xs + (size_t)(row - NTOK_P) * 2048;
            f32x4 v[8]; float ss = 0.f;
#pragma unroll
            for (int i = 0; i < 8; ++i) { v[i] = __builtin_nontemporal_load((const f32x4*)(xr + i * 256 + lane * 4)); ss += (v[i][0] * v[i][0] + v[i][1] * v[i][1]) + (v[i][2] * v[i][2] + v[i][3] * v[i][3]); }
            ss = wave_sum(ss);
            const float rs = rsqrtf(ss * (1.0f / 2048.0f) + EPS);
#pragma unroll
            for (int i = 0; i < 8; ++i) { u32x2 w; w.x = cvt_pk_bf16(v[i][0] * rs, v[i][1] * rs); w.y = cvt_pk_bf16(v[i][2] * rs, v[i][3] * rs); *(u32x2*)(X16 + (size_t)row * 2048 + i * 256 + lane * 4) = w; }
            if (lane == 0) rscale[row] = rs;
        }
    }
    if (inproj_rem(G) == 0) { transpose_tiles(p, lds, 1280, 2048, bid, G); build_tables(p, bid * 512 + tid, G * 512, G); }
}

__device__ __forceinline__ void spatial_units(const Params& p, LAS unsigned char* lds, int first, int stride) {
    const int tid = threadIdx.x, wid = __builtin_amdgcn_readfirstlane(tid >> 6), lane = tid & 63, fr = lane & 15, fq = lane >> 4;
    const bf16_t* Z = (const bf16_t*)(p.ws + WS_Z); const bf16_t* U = Z; const bf16_t* V = Z + PLANE; const bf16_t* GA = Z + 2 * PLANE;
    bf16_t* MIX = (bf16_t*)(p.ws + WS_MIX);
    constexpr int VS = 272, WOFF = 256 * VS;
    const int wr = wid >> 2, wc = wid & 3;
    const int pair = tid >> 3, oct = tid & 7, s0 = pair * 2;
    u32x4 r0[4], r1[4];
    int hcur = -1;
    if (first < 512) { const int h = first & 7, row0 = (first >> 3) * 128;
#pragma unroll
        for (int i = 0; i < 4; ++i) { const int pc = oct + 8 * i;
            r0[i] = __builtin_nontemporal_load((const u32x4*)(V + (size_t)(row0 + s0) * 2048 + h * 256 + pc * 8)); r1[i] = __builtin_nontemporal_load((const u32x4*)(V + (size_t)(row0 + s0 + 1) * 2048 + h * 256 + pc * 8)); } }
    for (int uid = first; uid < 512; uid += stride) {
        const int h = uid & 7, row0 = (uid >> 3) * 128;
        if (h != hcur) {
            const bf16_t* W = (const bf16_t*)(p.ws + WS_WS16) + (size_t)h * 16384;
#pragma unroll
            for (int i = 0; i < 4; ++i) { const int row = tid >> 2, piece = (tid & 3) + 4 * i; *(LAS u32x4*)(lds + WOFF + row * VS + piece * 16) = *(const u32x4*)(W + row * 128 + piece * 8); }
            hcur = h;
        }
        {
            float ss0 = 0.f, ss1 = 0.f;
#pragma unroll
            for (int i = 0; i < 4; ++i)
#pragma unroll
                for (int w = 0; w < 4; ++w) { const float a = bflo(r0[i][w]), b = bfhi(r0[i][w]), c = bflo(r1[i][w]), d = bfhi(r1[i][w]); ss0 += a * a + b * b; ss1 += c * c + d * d; }
            ss0 += __shfl_xor(ss0, 1); ss0 += __shfl_xor(ss0, 2); ss0 += __shfl_xor(ss0, 4);
            ss1 += __shfl_xor(ss1, 1); ss1 += __shfl_xor(ss1, 2); ss1 += __shfl_xor(ss1, 4);
            const float rs0 = rsqrtf(ss0 * (1.0f / 256.0f) + EPS), rs1 = rsqrtf(ss1 * (1.0f / 256.0f) + EPS);
#pragma unroll
            for (int i = 0; i < 4; ++i) { const int pc = oct + 8 * i;
                const f32x4 g0 = *(const f32x4*)(p.g_v + h * 256 + pc * 8), g1 = *(const f32x4*)(p.g_v + h * 256 + pc * 8 + 4);
#pragma unroll
                for (int w = 0; w < 4; ++w) {
                    const float ga = (w < 2) ? g0[2 * w] : g1[2 * w - 4], gb = (w < 2) ? g0[2 * w + 1] : g1[2 * w - 3];
                    const int d = pc * 8 + 2 * w;
                    *(LAS unsigned*)(lds + d * VS + s0 * 2) = cvt_pk_bf16(bflo(r0[i][w]) * rs0 * ga, bflo(r1[i][w]) * rs1 * ga);
                    *(LAS unsigned*)(lds + (d + 1) * VS + s0 * 2) = cvt_pk_bf16(bfhi(r0[i][w]) * rs0 * gb, bfhi(r1[i][w]) * rs1 * gb);
                }
            }
        }
        __syncthreads();
        if (uid + stride < 512) { const int un = uid + stride, hn = un & 7, rn = (un >> 3) * 128;
#pragma unroll
            for (int i = 0; i < 4; ++i) { const int pc = oct + 8 * i;
                r0[i] = __builtin_nontemporal_load((const u32x4*)(V + (size_t)(rn + s0) * 2048 + hn * 256 + pc * 8)); r1[i] = __builtin_nontemporal_load((const u32x4*)(V + (size_t)(rn + s0 + 1) * 2048 + hn * 256 + pc * 8)); } }
        float bsv[4];
#pragma unroll
        for (int mt = 0; mt < 4; ++mt) bsv[mt] = p.b_s[h * 128 + wr * 64 + mt * 16 + fr];
        f32x4 acc[4][4];
#pragma unroll
        for (int a = 0; a < 4; ++a)
#pragma unroll
            for (int b = 0; b < 4; ++b) acc[a][b] = (f32x4){0.f, 0.f, 0.f, 0.f};
#pragma unroll
        for (int kt = 0; kt < 4; ++kt) {
            if (32 * kt <= wr * 64 + 63) {
                bf16x8 wf[4], vf[4];
#pragma unroll
                for (int mt = 0; mt < 4; ++mt) wf[mt] = *(const LAS bf16x8*)(lds + WOFF + (wr * 64 + mt * 16 + fr) * VS + (32 * kt + 8 * fq) * 2);
#pragma unroll
                for (int nt = 0; nt < 4; ++nt) vf[nt] = *(const LAS bf16x8*)(lds + (wc * 64 + nt * 16 + fr) * VS + (32 * kt + 8 * fq) * 2);
#pragma unroll
                for (int mt = 0; mt < 4; ++mt)
#pragma unroll
                    for (int nt = 0; nt < 4; ++nt) acc[mt][nt] = __builtin_amdgcn_mfma_f32_16x16x32_bf16(vf[nt], wf[mt], acc[mt][nt], 0, 0, 0);
            }
        }
#pragma unroll
        for (int mt = 0; mt < 4; ++mt) {
            const int t = wr * 64 + mt * 16 + fr; const size_t row = (size_t)(row0 + t); const float bs = bsv[mt];
            u32x2 uu[4];
#pragma unroll
            for (int nt = 0; nt < 4; ++nt) { const int d0 = h * 256 + wc * 64 + nt * 16 + 4 * fq; uu[nt] = *(const u32x2*)(U + row * 2048 + d0); }
#pragma unroll
            for (int nt = 0; nt < 4; ++nt) {
                const int d0 = h * 256 + wc * 64 + nt * 16 + 4 * fq;
                const u32x2 u2 = uu[nt];
                u32x2 o;
                o.x = cvt_pk_bf16(bflo(u2.x) * (acc[mt][nt][0] + bs), bfhi(u2.x) * (acc[mt][nt][1] + bs));
                o.y = cvt_pk_bf16(bflo(u2.y) * (acc[mt][nt][2] + bs), bfhi(u2.y) * (acc[mt][nt][3] + bs));
                *(u32x2*)(MIX + row * 4096 + d0) = o;
            }
        }
        __syncthreads();
    }
}

__device__ __forceinline__ void spatial_sample_task(const Params& p, int seq, int h, int lane) {
    const bf16_t* Z = (const bf16_t*)(p.ws + WS_Z); const bf16_t* U = Z; const bf16_t* V = Z + PLANE; const bf16_t* GA = Z + 2 * PLANE;
    bf16_t* MIX = (bf16_t*)(p.ws + WS_MIX);
    const int c0 = h * 256 + lane * 4;
    const f32x4 gv = *(const f32x4*)(p.g_v + c0);
    f32x4 vn[8];
#pragma unroll
    for (int j = 0; j < 8; ++j) {
        const size_t row = (size_t)(NTOK_P + seq * 8 + j);
        const u32x2 r = *(const u32x2*)(V + row * 2048 + c0);
        f32x4 x = (f32x4){bflo(r.x), bfhi(r.x), bflo(r.y), bfhi(r.y)};
        const float ss = wave_sum((x[0] * x[0] + x[1] * x[1]) + (x[2] * x[2] + x[3] * x[3]));
        const float rs = rsqrtf(ss * (1.0f / 256.0f) + EPS);
        vn[j] = x * rs * gv;
        __builtin_nontemporal_store(vn[j], (f32x4*)(p.out + O_V + (size_t)(seq * 8 + j) * 2048 + c0));
    }
#pragma unroll
    for (int t = 0; t < 8; ++t) {
        const float bs = p.b_s[h * 128 + t];
        f32x4 m = (f32x4){bs, bs, bs, bs};
#pragma unroll
        for (int s = 0; s <= t; ++s) m += p.w_s[(size_t)(h * 128 + t) * 128 + s] * vn[s];
        const size_t row = (size_t)(NTOK_P + seq * 8 + t);
        const u32x2 uu = *(const u32x2*)(U + row * 2048 + c0);
        u32x2 o;
        o.x = cvt_pk_bf16(bflo(uu.x) * m[0], bfhi(uu.x) * m[1]);
        o.y = cvt_pk_bf16(bflo(uu.y) * m[2], bfhi(uu.y) * m[3]);
        *(u32x2*)(MIX + row * 4096 + c0) = o;
    }
}

__device__ __forceinline__ void s5_task(const Params& p, LAS unsigned char* wl, int task, int lane) {
    const bool sample = task >= 512;
    const int g = task & 127;
    int row0, ntiles, seq0 = 0; float* ore; float* oim;
    if (!sample) { const int b = task >> 7; row0 = b * 2048; ntiles = 64; ore = p.out + O_RE_P + (size_t)(b * 128 + g) * 64; oim = p.out + O_IM_P + (size_t)(b * 128 + g) * 64; }
    else { const int tb = (task - 512) >> 7; row0 = NTOK_P + tb * 256; ntiles = 8; seq0 = tb * 32; ore = p.out + O_RE_S + (size_t)g * 64; oim = p.out + O_IM_S + (size_t)g * 64; }
    const int r = lane & 31, hh = lane >> 5, fr = lane & 15, fq = lane >> 4;
    const float* lam = (const float*)(p.ws + WS_LAM);
    const float lr = lam[(g * 64 + lane) * 2], li = lam[(g * 64 + lane) * 2 + 1];
    const bf16_t* Bt = (const bf16_t*)(p.ws + WS_BT); const bf16_t* Ct = (const bf16_t*)(p.ws + WS_CT);
    bf16x8 btf[4], ctf[4];
#pragma unroll
    for (int mt = 0; mt < 4; ++mt) btf[mt] = *(const bf16x8*)(Bt + ((size_t)(g * 128 + 32 * mt + r) * 16 + 8 * hh));
#pragma unroll
    for (int kt = 0; kt < 4; ++kt) ctf[kt] = *(const bf16x8*)(Ct + ((size_t)(g * 16 + fr) * 128 + 32 * kt + 8 * fq));
    const f32x4 dsk = *(const f32x4*)(p.d_skip + g * 16 + 4 * fq);
    const bf16_t* XB = (const bf16_t*)(p.ws + WS_Z) + 3 * PLANE; bf16_t* YB = (bf16_t*)(p.ws + WS_YB);
    float hre = 0.f, him = 0.f;
    bf16x8 uf = *(const bf16x8*)(XB + (size_t)(row0 + r) * 2048 + g * 16 + 8 * hh);
    u32x2 ue0 = *(const u32x2*)(XB + (size_t)(row0 + fr) * 2048 + g * 16 + 4 * fq), ue1 = *(const u32x2*)(XB + (size_t)(row0 + 16 + fr) * 2048 + g * 16 + 4 * fq);
    for (int ti = 0; ti < ntiles; ++ti) {
        const int R = row0 + 32 * ti;
        float h0r[4] = {0.f, 0.f, 0.f, 0.f}, h0i[4] = {0.f, 0.f, 0.f, 0.f};
        if (sample) {
#pragma unroll
            for (int q = 0; q < 4; ++q) { const size_t o = ((size_t)(seq0 + ti * 4 + q) * 128 + g) * 64 + lane; h0r[q] = p.sre[o]; h0i[q] = p.sim[o]; }
        }
#pragma unroll
        for (int mt = 0; mt < 4; ++mt) {
            f32x16 a = {0.f, 0.f, 0.f, 0.f, 0.f, 0.f, 0.f, 0.f, 0.f, 0.f, 0.f, 0.f, 0.f, 0.f, 0.f, 0.f};
            a = __builtin_amdgcn_mfma_f32_32x32x16_bf16(btf[mt], uf, a, 0, 0, 0);
#pragma unroll
            for (int i = 0; i < 4; ++i) *(LAS f32x4*)(wl + r * S5_ROWB + (32 * mt + 8 * i + 4 * hh) * 4) = (f32x4){a[4 * i], a[4 * i + 1], a[4 * i + 2], a[4 * i + 3]};
        }
        const u32x2 uc0 = ue0, uc1 = ue1;
        if (ti + 1 < ntiles) {
            uf = *(const bf16x8*)(XB + (size_t)(R + 32 + r) * 2048 + g * 16 + 8 * hh);
            ue0 = *(const u32x2*)(XB + (size_t)(R + 32 + fr) * 2048 + g * 16 + 4 * fq); ue1 = *(const u32x2*)(XB + (size_t)(R + 48 + fr) * 2048 + g * 16 + 4 * fq);
        }
        WAVE_ORDER();
        f32x2v buv[32];
#pragma unroll
        for (int t = 0; t < 32; ++t) buv[t] = *(const LAS f32x2v*)(wl + t * S5_ROWB + lane * 8);
#pragma unroll
        for (int t = 0; t < 32; ++t) {
            if (sample && (t & 7) == 0) { hre = h0r[t >> 3]; him = h0i[t >> 3]; }
            const f32x2v bu = buv[t];
            float nre = fmaf(lr, hre, bu.x); nre = fmaf(-li, him, nre);
            float nim = fmaf(lr, him, bu.y); nim = fmaf(li, hre, nim);
            hre = nre; him = nim;
            *(LAS unsigned*)(wl + t * S5_ROWB + lane * 4) = cvt_pk_bf16(hre, him);
            if (sample && (t & 7) == 7) { const size_t o = (size_t)(seq0 + ti * 4 + (t >> 3)) * 8192 + lane; ore[o] = hre; oim[o] = him; }
        }
        WAVE_ORDER();
#pragma unroll
        for (int mt2 = 0; mt2 < 2; ++mt2) {
            f32x4 a2 = (f32x4){0.f, 0.f, 0.f, 0.f};
#pragma unroll
            for (int kt = 0; kt < 4; ++kt) {
                const bf16x8 hf = *(const LAS bf16x8*)(wl + (16 * mt2 + fr) * S5_ROWB + (32 * kt + 8 * fq) * 2);
                a2 = __builtin_amdgcn_mfma_f32_16x16x32_bf16(ctf[kt], hf, a2, 0, 0, 0);
            }
            const u32x2 uc = mt2 ? uc1 : uc0;
            const f32x2v ya = act_pk((f32x2v){a2[0], a2[1]} + (f32x2v){dsk[0], dsk[1]} * (f32x2v){bflo(uc.x), bfhi(uc.x)}, -1.44269504f * 1.5957691216f, -1.44269504f * 0.0713548163f);
            const f32x2v yb2 = act_pk((f32x2v){a2[2], a2[3]} + (f32x2v){dsk[2], dsk[3]} * (f32x2v){bflo(uc.y), bfhi(uc.y)}, -1.44269504f * 1.5957691216f, -1.44269504f * 0.0713548163f);
            u32x2 o; o.x = cvt_pk_bf16(ya.x, ya.y); o.y = cvt_pk_bf16(yb2.x, yb2.y);
            *(u32x2*)(YB + (size_t)(R + 16 * mt2 + fr) * 2048 + g * 16 + 4 * fq) = o;
        }
        WAVE_ORDER();
    }
    if (!sample) { ore[lane] = hre; oim[lane] = him; }
}

__device__ __forceinline__ void phase2(const Params& p, LAS unsigned char* lds) {
    const int tid = threadIdx.x, G = gridDim.x, bid = blockIdx.x, wid = __builtin_amdgcn_readfirstlane(tid >> 6), lane = tid & 63;
    const int nS5 = G / 2;
    if (bid < nS5) {
        LAS unsigned char* wl = lds + wid * S5_WAVE_B;
        if (wid < 4) { for (int t = bid * 4 + wid; t < 512; t += nS5 * 4) s5_task(p, wl, t, lane); }
        else { for (int t = 512 + bid * 4 + (wid - 4); t < 1024; t += nS5 * 4) s5_task(p, wl, t, lane); }
    } else {
        const int nA = G - nS5, ba = bid - nS5;
        spatial_units(p, lds, ba, nA);
        for (int t = ba * 8 + wid; t < 1024; t += nA * 8) spatial_sample_task(p, t >> 3, t & 7, lane);
    }
}

__global__ void __launch_bounds__(512, 2) hymba_fwd(Params p) {
    extern __shared__ __attribute__((aligned(16))) unsigned char smem[];
    LAS unsigned char* lds = (LAS unsigned char*)smem;
    cg::grid_group grid = cg::this_grid();
    if (p.ws == nullptr) grid.sync();
    if (threadIdx.x < 4) ((LAS unsigned*)(lds + LDS_MAIN))[threadIdx.x] = 0u;
    __syncthreads();
    XcdBarrier bar = xcd_barrier_post((unsigned*)(p.ws + WS_BAR), (volatile LAS unsigned*)(lds + LDS_MAIN));
    const int G = gridDim.x, bid = blockIdx.x;
    unsigned char* ws = p.ws;
    bf16_t* Z = (bf16_t*)(ws + WS_Z);

    for (int rep = 0; rep < REP0; ++rep) phase0(p, lds);
    xcd_barrier(bar);
    {
        pg8::Gemm g{(const bf16_t*)(ws + WS_X16), (const bf16_t*)(ws + WS_WINT), NTOK, 10240, 2048};
        pg8::StaticOrder S; S.init(NTOK, 10240, 2048, G, bid);
        EpiInProj E{Z, (const float*)(ws + WS_RSCALE)};
        pg8::gemm_phase<EpiInProj, pg8::StaticOrder>(lds, g, S, E);
    }
    { const int rem = inproj_rem(G);
      if (rem != 0 && bid >= rem) { transpose_tiles(p, lds, 1280, 2048, bid - rem, G - rem); build_tables(p, (bid - rem) * 512 + (int)threadIdx.x, (G - rem) * 512, G); } }
    xcd_barrier(bar);
    for (int rep = 0; rep < REP2; ++rep) phase2(p, lds);
    xcd_barrier(bar);
    {
        pg8::Gemm g{(const bf16_t*)(ws + WS_YB), (const bf16_t*)(ws + WS_WGLU), NTOK, 2048, 2048};
        pg8::StaticOrder S; S.init(NTOK, 2048, 2048, G, bid, 8);
        if (S.split_active()) S.cnt = (unsigned*)(ws + WS_CNT) + (bid / S.nsplit) * 64;
        EpiGlu E{(const bf16_t*)(ws + WS_YB), Z + 4 * PLANE, p.b_glu, (bf16_t*)(ws + WS_MIX), (float*)(ws + WS_PART), (S.split_active() ? bid / S.nsplit : 0)};
        pg8::gemm_phase<EpiGlu, pg8::StaticOrder>(lds, g, S, E);
        if (S.split_active()) glu_tail_reduce(p, S, G);
    }
    xcd_barrier(bar);
    if (G == 256) {
        {
            pg8::Gemm g{(const bf16_t*)(ws + WS_MIX), (const bf16_t*)(ws + WS_WOUT), NTOK, 2048, 4096};
            OutOrder S{bid};
            EpiOutF E{p.xp, p.out, p.g_final, ws};
            pg8::gemm_phase<EpiOutF, OutOrder>(lds, g, S, E);
        }
        xcd_barrier(bar);
        {
            const int tid = threadIdx.x, wid = tid >> 6, lane = tid & 63, rsub = wid >> 1, half = wid & 1;
            const bf16_t* part = (const bf16_t*)(ws + WS_PART);
            LAS float* sx = (LAS float*)lds;
            for (int r0 = bid * 4; r0 < 1024; r0 += G * 4) {
                const int r = r0 + rsub;
                float* o = p.out + (size_t)(NTOK_P + r) * 2048; const float* xr = p.xs + (size_t)r * 2048;
                const int tub = (r >> 8) * 8 + half * 4;
                f32x4 a[4]; u32x2 q[4][8];
#pragma unroll
                for (int i = 0; i < 4; ++i) {
                    a[i] = __builtin_nontemporal_load((const f32x4*)(xr + (half * 4 + i) * 256 + lane * 4));
                    const bf16_t* pp = part + (size_t)(tub + i) * 65536 + (size_t)(r & 255) * 256 + lane * 4;
#pragma unroll
                    for (int kc = 0; kc < 8; ++kc) q[i][kc] = *(const u32x2*)(pp + (size_t)kc * 32 * 65536);
                }
                float ss = 0.f;
#pragma unroll
                for (int i = 0; i < 4; ++i) {
#pragma unroll
                    for (int kc = 0; kc < 8; ++kc) a[i] += (f32x4){bflo(q[i][kc].x), bfhi(q[i][kc].x), bflo(q[i][kc].y), bfhi(q[i][kc].y)};
                    ss += (a[i][0] * a[i][0] + a[i][1] * a[i][1]) + (a[i][2] * a[i][2] + a[i][3] * a[i][3]);
                }
                ss = wave_sum(ss);
                if (lane == 0) sx[wid] = ss;
                __syncthreads();
                const float rs = rsqrtf((sx[rsub * 2] + sx[rsub * 2 + 1]) * (1.0f / 2048.0f) + EPS);
#pragma unroll
                for (int i = 0; i < 4; ++i) { const f32x4 gf = *(const f32x4*)(p.g_final + (half * 4 + i) * 256 + lane * 4); __builtin_nontemporal_store(a[i] * rs * gf, (f32x4*)(o + (half * 4 + i) * 256 + lane * 4)); }
                __syncthreads();
            }
        }
    }
}

extern "C" void kernel_launch(void* const* d_in, const int* in_sizes, int n_in, void* d_out, int out_size, void* d_ws, size_t ws_size, hipStream_t stream) {
    static int grid_blocks = 0;
    if (grid_blocks == 0) {
        if (n_in != 21 || ws_size < WS_END) { fprintf(stderr, "kernel_launch: unexpected n_in %d / ws_size %zu (need %zu)\n", n_in, ws_size, (size_t)WS_END); grid_blocks = -1; return; }
        int dev = 0, cus = 0, per_cu = 0;
        hipGetDevice(&dev);
        hipDeviceGetAttribute(&cus, hipDeviceAttributeMultiprocessorCount, dev);
        if (hipFuncSetAttribute((const void*)hymba_fwd, hipFuncAttributeMaxDynamicSharedMemorySize, LDS_BYTES) != hipSuccess) { fprintf(stderr, "kernel_launch: hipFuncSetAttribute failed\n"); grid_blocks = -1; return; }
        if (hipOccupancyMaxActiveBlocksPerMultiprocessor(&per_cu, (const void*)hymba_fwd, 512, LDS_BYTES) != hipSuccess || per_cu < 1) { fprintf(stderr, "kernel_launch: occupancy query gave %d\n", per_cu); per_cu = 1; (void)hipGetLastError(); }
        grid_blocks = 256;
        if (cus != 256) fprintf(stderr, "kernel_launch: built for a 256-CU device, found %d CUs\n", cus);
    }
    if (grid_blocks < 0) return;
    if (hipMemsetAsync((char*)d_ws + WS_BAR, 0, 16384, stream) != hipSuccess) { fprintf(stderr, "kernel_launch: memset of the barrier words failed\n"); return; }
    Params p{};
    p.xp = (const float*)d_in[0]; p.xs = (const float*)d_in[1]; p.sre = (const float*)d_in[2]; p.sim = (const float*)d_in[3]; p.g_norm = (const float*)d_in[4];
    p.w_in = (const float*)d_in[5]; p.g_v = (const float*)d_in[6]; p.w_s = (const float*)d_in[7]; p.b_s = (const float*)d_in[8]; p.a_re = (const float*)d_in[9];
    p.a_im = (const float*)d_in[10]; p.log_dt = (const float*)d_in[11]; p.b_re = (const float*)d_in[12]; p.b_im = (const float*)d_in[13]; p.c_re = (const float*)d_in[14];
    p.c_im = (const float*)d_in[15]; p.d_skip = (const float*)d_in[16]; p.w_glu = (const float*)d_in[17]; p.b_glu = (const float*)d_in[18]; p.w_out = (const float*)d_in[19];
    p.g_final = (const float*)d_in[20]; p.out = (float*)d_out; p.ws = (unsigned char*)d_ws;
    void* args[] = {&p};
    hipError_t e = hipLaunchCooperativeKernel((const void*)hymba_fwd, dim3(grid_blocks), dim3(512), args, LDS_BYTES, stream);
    if (e != hipSuccess) fprintf(stderr, "cooperative launch failed: %s (grid %d)\n", hipGetErrorString(e), grid_blocks);
}
```

```cpp
#include <hip/hip_runtime.h>
#include <hip/hip_cooperative_groups.h>
#include <cstdio>
namespace cg = cooperative_groups;

namespace pg8 {
#define PG8_LAS __attribute__((address_space(3)))
typedef unsigned short bf16_t;
typedef short bf16x8 __attribute__((ext_vector_type(8)));
typedef float f32x4 __attribute__((ext_vector_type(4)));
typedef unsigned u32x4 __attribute__((ext_vector_type(4)));
constexpr int BM = 256, BK = 64, HALF = 128, HTB = HALF * BK * 2  , STAGE_BYTES = 8 * HTB, NXCD = 8, WGM = 8;

__host__ __device__ __forceinline__ int lds_byte(int r, int c) { const int st = (r >> 4) * 2 + (c >> 5), rr = r & 15, cc = c & 31, ob = rr * 64 + cc * 2; return st * 1024 + (ob ^ (((ob >> 9) & 1) << 5)); }
__host__ __device__ __forceinline__ void stage_rc(int b, int& R, int& C) { const int st = b / 1024, sb = b % 1024, swz = sb ^ (((sb >> 9) & 1) << 5); R = (st >> 1) * 16 + swz / 64; C = (st & 1) * 32 + (swz % 64) / 2; }
__host__ __device__ __forceinline__ int perm32(int rho) { const int n = rho >> 4, i = rho & 15; return 8 * (i >> 2) + 4 * n + (i & 3); }

struct Unit { int pm, pn, k0, nkt; };
struct Gemm { const bf16_t* A; const bf16_t* Bt; int M, N, K; };

struct StaticOrder {
    int nM, nN, nwg, G, c, nkt, nsplit; unsigned* cnt = nullptr;
    __host__ __device__ void init(int M, int N, int K, int G_, int c_, int nsplit_ = 1) { nM = M / BM; nN = N / BM; nwg = nM * nN; G = G_; c = c_; nkt = K / BK;
        nsplit = ((nwg % G) * nsplit_ == G && (nkt / nsplit_) >= 4 && (nkt % (2 * nsplit_)) == 0) ? nsplit_ : 1; }
    __host__ __device__ bool split_active() const { return nsplit > 1; }
    __host__ __device__ void map(int wgid, Unit& u) const {
        { const int q = nwg / NXCD, r = nwg % NXCD, xcd = wgid % NXCD, off = wgid / NXCD; wgid = (xcd < r ? xcd * (q + 1) : r * (q + 1) + (xcd - r) * q) + off; }
        const int nig = WGM * nN, gid = wgid / nig, fm = gid * WGM, gsz = (nM - fm) < WGM ? (nM - fm) : WGM;
        u.pm = fm + ((wgid % nig) % gsz); u.pn = (wgid % nig) / gsz; u.k0 = 0; u.nkt = nkt; }
    __host__ __device__ bool next(int i, Unit& u) const {
        const int full = nwg / G;
        if (nsplit > 1) {
            if (i < full) { map(i * G + c, u); return true; }
            if (i > full) { map(0, u); return false; }
            map(full * G + c / nsplit, u); u.nkt = nkt / nsplit; u.k0 = (c % nsplit) * u.nkt * BK; return true; }
        const long L = (long)i * G + c; if (L >= nwg) { map(0, u); return false; }
        map((int)L, u); return true;
    }
    __device__ __forceinline__ void a_ready(const Unit&) const {}
    __device__ __forceinline__ void done(const Unit& u) const {
        if (cnt != nullptr && u.nkt != nkt) { asm volatile("s_waitcnt vmcnt(0)" ::: "memory");
            if ((threadIdx.x & 63) == 0) __hip_atomic_fetch_add(cnt, 1u, __ATOMIC_RELAXED, __HIP_MEMORY_SCOPE_AGENT); } }
};
__device__ __forceinline__ unsigned cvt_pk_bf16(float lo, float hi) { unsigned r; asm("v_cvt_pk_bf16_f32 %0, %1, %2" : "=v"(r) : "v"(lo), "v"(hi)); return r; }
typedef float f32x2 __attribute__((ext_vector_type(2)));
template <class Epi, class Sched>
__device__ __forceinline__ void gemm_phase(PG8_LAS unsigned char* lds, const Gemm g, const Sched& S, const Epi& E) {
    const int tid = threadIdx.x, wid = __builtin_amdgcn_readfirstlane(tid >> 6), lane = tid & 63, wr = wid >> 2, wc = wid & 3, fr = lane & 15, fq = lane >> 4;
    const int K = g.K;
    unsigned voffA[2], voffB[2];
#pragma unroll
    for (int i = 0; i < 2; ++i) { int R, C; stage_rc(tid * 16 + i * 8192, R, C); const int Rb = Epi::PERM ? ((R & ~31) + perm32(R & 31)) : R;
        voffA[i] = (unsigned)(R * K + C) * 2u; voffB[i] = (unsigned)(Rb * K + C) * 2u; }
    const size_t kstep = (size_t)(BK * 2);
    const size_t hstep = (size_t)HALF * K * 2;
    const size_t tstep = 2 * hstep;
    const unsigned ldsw = (unsigned)wid * 1024u;
    const int aoff = lds_byte(wr * 64 + fr, fq * 8), boff = lds_byte(wc * 32 + fr, fq * 8);
#define PG8_SA(b, h) (((b) * 2 + (h)) * HTB)
#define PG8_SB(b, h) ((4 + (b) * 2 + (h)) * HTB)
#define PG8_STAGE(bufoff, gbase, voff) do { _Pragma("unroll") for (int _i = 0; _i < 2; ++_i) \
        __builtin_amdgcn_global_load_lds((const unsigned*)((const char*)(gbase) + (voff)[_i]), (PG8_LAS unsigned*)(lds + (bufoff) + ldsw + _i * 8192), 16, 0, 0); } while (0)
#define PG8_LDA(dst, b, h) do { _Pragma("unroll") for (int m = 0; m < 4; ++m) _Pragma("unroll") for (int k = 0; k < 2; ++k) dst[m][k] = *(const PG8_LAS bf16x8*)(lds + PG8_SA(b, h) + aoff + m * 2048 + k * 1024); } while (0)
#define PG8_LDB(dst, b, h) do { _Pragma("unroll") for (int n = 0; n < 2; ++n) _Pragma("unroll") for (int k = 0; k < 2; ++k) dst[n][k] = *(const PG8_LAS bf16x8*)(lds + PG8_SB(b, h) + boff + n * 2048 + k * 1024); } while (0)
#define PG8_MMA(ai, bj, At, Bt) do { __builtin_amdgcn_s_setprio(1); _Pragma("unroll") for (int m = 0; m < 4; ++m) _Pragma("unroll") for (int n = 0; n < 2; ++n) _Pragma("unroll") for (int k = 0; k < 2; ++k) \
        acc[ai][bj][m][n] = __builtin_amdgcn_mfma_f32_16x16x32_bf16(Bt[n][k], At[m][k], acc[ai][bj][m][n], 0, 0, 0); __builtin_amdgcn_s_setprio(0); } while (0)
#define PG8_WAIT_V(n) asm volatile("s_waitcnt vmcnt(" #n ")" ::: "memory")
#define PG8_WAIT_L(n) asm volatile("s_waitcnt lgkmcnt(" #n ")" ::: "memory")
#define PG8_BAR __builtin_amdgcn_s_barrier()
#define PG8_SCHED __builtin_amdgcn_sched_barrier(0)
    Unit cur, nxt; int ui = 0;
    if (!S.next(0, cur)) return;
    f32x4 acc[2][2][4][2];
#pragma unroll
    for (int a = 0; a < 2; ++a)
#pragma unroll
        for (int b = 0; b < 2; ++b)
#pragma unroll
            for (int m = 0; m < 4; ++m)
#pragma unroll
                for (int n = 0; n < 2; ++n) acc[a][b][m][n] = (f32x4){0.f, 0.f, 0.f, 0.f};
    bf16x8 At[4][2], B0[2][2], B1[2][2];
    const char* cA = (const char*)g.A + (size_t)cur.pm * tstep + (size_t)cur.k0 * 2; const char* cB = (const char*)g.Bt + (size_t)cur.pn * tstep + (size_t)cur.k0 * 2;
    S.a_ready(cur);
    PG8_STAGE(PG8_SB(0, 0), cB, voffB); PG8_STAGE(PG8_SA(0, 0), cA, voffA); PG8_STAGE(PG8_SB(0, 1), cB + hstep, voffB); PG8_STAGE(PG8_SA(0, 1), cA + hstep, voffA);
    if (wr == 1) PG8_BAR;
    PG8_WAIT_V(4); PG8_BAR;
    PG8_STAGE(PG8_SB(1, 0), cB + kstep, voffB); PG8_STAGE(PG8_SA(1, 0), cA + kstep, voffA); PG8_STAGE(PG8_SB(1, 1), cB + hstep + kstep, voffB);
    PG8_WAIT_V(6); PG8_BAR;
    for (;;) {
        const bool has_next = S.next(ui + 1, nxt);
        const char* nA = has_next ? (const char*)g.A + (size_t)nxt.pm * tstep + (size_t)nxt.k0 * 2 : cA; const char* nB = has_next ? (const char*)g.Bt + (size_t)nxt.pn * tstep + (size_t)nxt.k0 * 2 : cB;
        const int nt = cur.nkt;
        for (int t = 0; t < nt; t += 2) {
            const bool last = (t == nt - 2);
            const char* a1 = cA + (size_t)(t + 1) * kstep;
            const char* a2 = last ? nA : cA + (size_t)(t + 2) * kstep; const char* b2 = last ? nB : cB + (size_t)(t + 2) * kstep;
            const char* a3 = a2 + kstep; const char* b3 = b2 + kstep;
            if (last && has_next) S.a_ready(nxt);
            PG8_LDB(B0, 0, 0); PG8_SCHED; PG8_LDA(At, 0, 0); PG8_STAGE(PG8_SA(1, 1), a1 + hstep, voffA);
            PG8_WAIT_L(8); PG8_BAR; PG8_WAIT_L(0); PG8_MMA(0, 0, At, B0); PG8_BAR; PG8_SCHED;
            PG8_LDB(B1, 0, 1); PG8_STAGE(PG8_SB(0, 0), b2, voffB);
            PG8_BAR; PG8_WAIT_L(0); PG8_MMA(0, 1, At, B1); PG8_BAR;
            PG8_LDA(At, 0, 1); PG8_STAGE(PG8_SA(0, 0), a2, voffA);
            PG8_BAR; PG8_WAIT_L(0); PG8_MMA(1, 0, At, B0); PG8_BAR; PG8_SCHED;
            PG8_STAGE(PG8_SB(0, 1), b2 + hstep, voffB);
            PG8_WAIT_V(6); PG8_BAR; PG8_MMA(1, 1, At, B1); PG8_BAR;
            PG8_LDB(B0, 1, 0); PG8_SCHED; PG8_LDA(At, 1, 0); PG8_STAGE(PG8_SA(0, 1), a2 + hstep, voffA);
            PG8_WAIT_L(8); PG8_BAR; PG8_WAIT_L(0); PG8_MMA(0, 0, At, B0); PG8_BAR; PG8_SCHED;
            PG8_LDB(B1, 1, 1); PG8_STAGE(PG8_SB(1, 0), b3, voffB);
            PG8_BAR; PG8_WAIT_L(0); PG8_MMA(0, 1, At, B1); PG8_BAR;
            PG8_LDA(At, 1, 1); PG8_STAGE(PG8_SA(1, 0), a3, voffA);
            PG8_BAR; PG8_WAIT_L(0); PG8_MMA(1, 0, At, B0); PG8_BAR; PG8_SCHED;
            PG8_STAGE(PG8_SB(1, 1), b3 + hstep, voffB);
            PG8_WAIT_V(6); PG8_BAR; PG8_MMA(1, 1, At, B1); PG8_BAR;
        }
        if (!Epi::AFTER_DRAIN || has_next) { E(acc, cur, wr, wc, fr, fq); S.done(cur); }
        if (!has_next) break;
#pragma unroll
        for (int a = 0; a < 2; ++a)
#pragma unroll
            for (int b = 0; b < 2; ++b)
#pragma unroll
                for (int m = 0; m < 4; ++m)
#pragma unroll
                    for (int n = 0; n < 2; ++n) acc[a][b][m][n] = (f32x4){0.f, 0.f, 0.f, 0.f};
        cur = nxt; cA = nA; cB = nB; ++ui;
    }
    PG8_WAIT_V(0);
    if (wr == 0) PG8_BAR;
    PG8_BAR;
    if constexpr (Epi::AFTER_DRAIN) { E.fused(acc, cur, wr, wc, fr, fq, lds, wid, lane); S.done(cur); }
#undef PG8_SA
#undef PG8_SB
#undef PG8_STAGE
#undef PG8_LDA
#undef PG8_LDB
#undef PG8_MMA
#undef PG8_WAIT_V
#undef PG8_WAIT_L
#undef PG8_BAR
#undef PG8_SCHED
}
}

using pg8::bf16_t; using pg8::bf16x8; using pg8::f32x4; using pg8::u32x4; using pg8::Unit; using pg8::cvt_pk_bf16;
#define LAS __attribute__((address_space(3)))
typedef float f32x16 __attribute__((ext_vector_type(16)));
typedef float f32x2v __attribute__((ext_vector_type(2)));
typedef unsigned u32x2 __attribute__((ext_vector_type(2)));

constexpr int NTOK_P = 8192, NTOK = 9216;
constexpr size_t PLANE = (size_t)NTOK * 2048;
constexpr float EPS = 1e-6f;

constexpr size_t WS_X16 = 0;
constexpr size_t WS_WINT = 37748736;
constexpr size_t WS_MIX = 0;
constexpr size_t WS_WGLU = 79691776;
constexpr size_t WS_WOUT = 88080384;
constexpr size_t WS_Z = 104857600;
constexpr size_t WS_RSCALE = 293601280;
constexpr size_t WS_SSQ = WS_RSCALE + 36864;
constexpr size_t WS_TAB = WS_SSQ;
constexpr size_t WS_CNT2 = WS_SSQ + 16384;
constexpr size_t WS_CNT = WS_SSQ + 4096;
constexpr size_t WS_PART = WS_Z;
constexpr size_t WS_LAM = WS_SSQ + 36864;
constexpr size_t WS_BT = WS_LAM + 65536;
constexpr size_t WS_CT = WS_BT + 524288;
constexpr size_t WS_WS16 = WS_CT + 524288;
constexpr size_t WS_YB = WS_WS16 + 262144;
constexpr size_t WS_EXCH = WS_YB + 37748736;
constexpr size_t WS_BAR = WS_EXCH + 294912;
constexpr size_t WS_END = WS_BAR + 16384;
constexpr int REP0 = 1, REP2 = 1, REP3 = 1;

constexpr size_t O_RE_P = 18874368, O_IM_P = 18907136, O_RE_S = 18939904, O_IM_S = 19988480, O_V = 21037056;

constexpr int S5_ROWB = 528;
constexpr int S5_WAVE_B = 32 * S5_ROWB;
constexpr int LDS_MAIN = 8 * S5_WAVE_B;
constexpr int LDS_BYTES = LDS_MAIN + 16;

struct Params {
    const float *xp, *xs, *sre, *sim, *g_norm, *w_in, *g_v, *w_s, *b_s, *a_re, *a_im, *log_dt, *b_re, *b_im, *c_re, *c_im, *d_skip, *w_glu, *b_glu, *w_out, *g_final;
    float* out; unsigned char* ws;
};

__device__ __forceinline__ float bflo(unsigned w) { return __uint_as_float(w << 16); }
__device__ __forceinline__ float bfhi(unsigned w) { return __uint_as_float(w & 0xffff0000u); }
__device__ __forceinline__ float sigmoid_fast(float t) { return __builtin_amdgcn_rcpf(1.0f + __builtin_amdgcn_exp2f(-1.44269504f * t)); }
__device__ __forceinline__ float gelu_tanh(float x) { return x * sigmoid_fast(x * (1.5957691216f + 0.0713548163f * x * x)); }
__device__ __forceinline__ float silu_f(float x) { return x * sigmoid_fast(x); }
__device__ __forceinline__ f32x2v act_pk(f32x2v x, float c1n, float c3n) {
    const f32x2v q = x * x;
    const f32x2v t = x * (q * c3n + c1n);
    f32x2v e; e.x = __builtin_amdgcn_exp2f(t.x); e.y = __builtin_amdgcn_exp2f(t.y);
    const f32x2v d = e + 1.0f;
    f32x2v r; r.x = __builtin_amdgcn_rcpf(d.x); r.y = __builtin_amdgcn_rcpf(d.y);
    return x * r;
}
__device__ __forceinline__ float wave_sum(float v) {
#pragma unroll
    for (int o = 32; o >= 1; o >>= 1) v += __shfl_xor(v, o);
    return v;
}
#define LGKM0() asm volatile("s_waitcnt lgkmcnt(0)" ::: "memory")
#define WAVE_ORDER() asm volatile("" ::: "memory")


#define XB_TMO      128
#define XB_XCNT(j)  (256  + 64 * (j))
#define XB_XSUB(j)  (1280 + 64 * (j))
#define XB_XGEN(j)  (2304 + 64 * (j))
#define XB_TOP      3328
#define XB_TOPGEN   3392
#define XCD_BAR_WORDS 3456
#define XB_SPIN_CAP (1u << 18)
__device__ __forceinline__ unsigned xb_ld(unsigned* p)              { return __hip_atomic_load(p, __ATOMIC_RELAXED, __HIP_MEMORY_SCOPE_AGENT); }
__device__ __forceinline__ unsigned xb_add(unsigned* p, unsigned v) { return __hip_atomic_fetch_add(p, v, __ATOMIC_RELAXED, __HIP_MEMORY_SCOPE_AGENT); }
__device__ __forceinline__ unsigned xb_xcc_id() { return (unsigned)__builtin_amdgcn_s_getreg((3 << 11) | 20) & 0xFu; }
#define XB_SPIN(cond, bar) do { unsigned _sp = 0; while (cond) { __builtin_amdgcn_s_sleep(1); \
    if ((++_sp & 255u) == 0u) { if (xb_ld(&(bar)[XB_TMO])) break; if (_sp > XB_SPIN_CAP) { atomicAdd(&(bar)[XB_TMO], 1u); break; } } } } while (0)

struct XcdBarrier {
    unsigned* bar; unsigned x;
    volatile LAS unsigned* st;
};

__device__ __forceinline__ XcdBarrier xcd_barrier_post(unsigned* bar, volatile LAS unsigned* st) {
    XcdBarrier b; b.bar = bar; b.x = xb_xcc_id(); b.st = st;
    if (threadIdx.x == 0) (void)xb_add(&bar[XB_XCNT(b.x)], 1u);
    return b;
}
__device__ __forceinline__ void xcd_barrier_complete(unsigned* bar, unsigned x, unsigned& nloc, unsigned& nx) {
    const unsigned G = gridDim.x * gridDim.y * gridDim.z;
    unsigned sum, cnt, mine, sp = 0u;
    for (;;) {
        sum = 0u; cnt = 0u; mine = 0u;
#pragma unroll
        for (unsigned j = 0; j < 16; ++j) { const unsigned c = xb_ld(&bar[XB_XCNT(j)]); sum += c; cnt += (c > 0u) ? 1u : 0u; mine = (j == x) ? c : mine; }
        if (sum == G) break;
        __builtin_amdgcn_s_sleep(1);
        if ((++sp & 255u) == 0u) { if (xb_ld(&bar[XB_TMO])) break; if (sp > XB_SPIN_CAP) { atomicAdd(&bar[XB_TMO], 1u); break; } }
    }
    nloc = mine > 0u ? mine : 1u; nx = cnt > 0u ? cnt : 1u;
}

__device__ __forceinline__ void xcd_barrier(const XcdBarrier& b) {
    asm volatile("s_waitcnt vmcnt(0)" ::: "memory");
    __syncthreads();
    if (threadIdx.x == 0) {
        unsigned* bar = b.bar;
        __builtin_amdgcn_s_waitcnt(0);
        unsigned nloc = b.st[0], nx = b.st[1];
        if (nloc == 0u) { xcd_barrier_complete(bar, b.x, nloc, nx); b.st[0] = nloc; b.st[1] = nx; }
        const unsigned old = xb_add(&bar[XB_XSUB(b.x)], 1u);
        const unsigned gen = old / nloc;
        if (old + 1u == (gen + 1u) * nloc) {
            __builtin_amdgcn_fence(__ATOMIC_RELEASE, "agent");
            asm volatile("s_waitcnt vmcnt(0)" ::: "memory");
            const unsigned og = xb_add(&bar[XB_TOP], 1u);
            const unsigned tg = og / nx;
            if (og + 1u == (tg + 1u) * nx) xb_add(&bar[XB_TOPGEN], 1u);
            else XB_SPIN(xb_ld(&bar[XB_TOPGEN]) == tg, bar);
            __builtin_amdgcn_fence(__ATOMIC_ACQUIRE, "agent");
            xb_add(&bar[XB_XGEN(b.x)], 1u);
            asm volatile("s_waitcnt vmcnt(0)" ::: "memory");
        } else {
            XB_SPIN(xb_ld(&bar[XB_XGEN(b.x)]) == gen, bar);
            __builtin_amdgcn_fence(__ATOMIC_ACQUIRE, "agent");
            asm volatile("s_waitcnt vmcnt(0)" ::: "memory");
        }
    }
    __syncthreads();
}

__device__ __forceinline__ float rsvc(const float (&a)[8], int i) { return a[i]; }
struct EpiInProj {
    static constexpr bool PERM = true, AFTER_DRAIN = false;
    bf16_t* Z; const float* rscale;
    __device__ __forceinline__ void operator()(const f32x4 (&acc)[2][2][4][2], const Unit& u, int wr, int wc, int fr, int fq) const {
        const int row0c = u.pm * 256 + wr * 64 + fr;
        if (u.pn < 16) {
            const int colc = u.pn * 128 + wc * 32 + 8 * fq;
#pragma unroll
            for (int ai = 0; ai < 2; ++ai)
#pragma unroll
                for (int m = 0; m < 4; ++m) {
                    f32x2v pr[4];
#pragma unroll
                    for (int n = 0; n < 2; ++n) { const f32x4 ua = acc[ai][0][m][n], ga = acc[ai][1][m][n];
                        pr[2 * n] = act_pk((f32x2v){ua[0], ua[1]}, -1.44269504f * 1.5957691216f, -1.44269504f * 0.0713548163f) * act_pk((f32x2v){ga[0], ga[1]}, -1.44269504f, 0.0f);
                        pr[2 * n + 1] = act_pk((f32x2v){ua[2], ua[3]}, -1.44269504f * 1.5957691216f, -1.44269504f * 0.0713548163f) * act_pk((f32x2v){ga[2], ga[3]}, -1.44269504f, 0.0f); }
                    u32x4 w; w.x = cvt_pk_bf16(pr[0].x, pr[0].y); w.y = cvt_pk_bf16(pr[1].x, pr[1].y); w.z = cvt_pk_bf16(pr[2].x, pr[2].y); w.w = cvt_pk_bf16(pr[3].x, pr[3].y);
                    *(u32x4*)(Z + (size_t)(row0c + ai * 128 + m * 16) * 2048 + colc) = w;
                }
            return;
        }
        const int sq = (u.pn >> 3) - 2;
        const int sec = (sq == 0) ? 1 : (sq == 1) ? 3 : 4;
        const float c1n = (sec < 2) ? -1.44269504f * 1.5957691216f : -1.44269504f, c3n = (sec < 2) ? -1.44269504f * 0.0713548163f : 0.0f;
        const bool ident = (sec == 3);
        bf16_t* base = Z + (size_t)sec * PLANE;
        const int row0 = u.pm * 256 + wr * 64 + fr, col0 = (u.pn & 7) * 256 + wc * 32 + 8 * fq;
#pragma unroll
        for (int ai = 0; ai < 2; ++ai)
#pragma unroll
            for (int m = 0; m < 4; ++m) {
                const int row = row0 + ai * 128 + m * 16;
                bf16_t* rowp = base + (size_t)row * 2048 + col0;
#pragma unroll
                for (int bj = 0; bj < 2; ++bj) {
                    f32x2v v2[4];
#pragma unroll
                    for (int n = 0; n < 2; ++n) { const f32x4 a4 = acc[ai][bj][m][n]; v2[2 * n] = (f32x2v){a4[0], a4[1]}; v2[2 * n + 1] = (f32x2v){a4[2], a4[3]}; }
                    if (!ident) {
#pragma unroll
                        for (int j = 0; j < 4; ++j) v2[j] = act_pk(v2[j], c1n, c3n);
                    }
                    u32x4 w; w.x = cvt_pk_bf16(v2[0].x, v2[0].y); w.y = cvt_pk_bf16(v2[1].x, v2[1].y); w.z = cvt_pk_bf16(v2[2].x, v2[2].y); w.w = cvt_pk_bf16(v2[3].x, v2[3].y);
                    *(u32x4*)(rowp + bj * 128) = w;
                }
            }
    }
};
struct EpiGlu {
    static constexpr bool PERM = true, AFTER_DRAIN = false;
    const bf16_t* YB; const bf16_t* SGB; const float* bias; bf16_t* MIX; float* part; int tu;
    __device__ __forceinline__ void operator()(const f32x4 (&acc)[2][2][4][2], const Unit& u, int wr, int wc, int fr, int fq) const {
        const int row0 = u.pm * 256 + wr * 64 + fr, col0 = u.pn * 256 + wc * 32 + 8 * fq;
        if (u.nkt != 32) {
            bf16_t* pt = (bf16_t*)part + ((size_t)(u.k0 / (u.nkt * 64)) * 32 + tu) * 65536 + (size_t)((wr * 4 + wc) * 16) * 512 + (fq * 16 + fr) * 8;
#pragma unroll
            for (int ai = 0; ai < 2; ++ai)
#pragma unroll
                for (int m = 0; m < 4; ++m)
#pragma unroll
                    for (int bj = 0; bj < 2; ++bj) {
                        const f32x4 v0 = acc[ai][bj][m][0], v1 = acc[ai][bj][m][1];
                        u32x4 w; w.x = cvt_pk_bf16(v0[0], v0[1]); w.y = cvt_pk_bf16(v0[2], v0[3]); w.z = cvt_pk_bf16(v1[0], v1[1]); w.w = cvt_pk_bf16(v1[2], v1[3]);
                        bf16_t* dst = pt + ((ai * 4 + m) * 2 + bj) * 512;
                        asm volatile("global_store_dwordx4 %0, %1, off sc1\n\ts_nop 2" :: "v"(dst), "v"(w) : "memory");
                    }
            return;
        }
        f32x4 bv[2][2];
#pragma unroll
        for (int bj = 0; bj < 2; ++bj)
#pragma unroll
            for (int n = 0; n < 2; ++n) bv[bj][n] = *(const f32x4*)(bias + col0 + bj * 128 + 4 * n);
#pragma unroll
        for (int ai = 0; ai < 4; ++ai) {
            u32x4 ybv[2][2], gbv[2][2];
#pragma unroll
            for (int m = 0; m < 2; ++m)
#pragma unroll
                for (int bj = 0; bj < 2; ++bj) { const size_t row = (size_t)(row0 + (ai >> 1) * 128 + ((ai & 1) * 2 + m) * 16);
                    ybv[m][bj] = *(const u32x4*)(YB + row * 2048 + col0 + bj * 128); gbv[m][bj] = *(const u32x4*)(SGB + row * 2048 + col0 + bj * 128); }
#pragma unroll
            for (int m = 0; m < 2; ++m) {
                const size_t row = (size_t)(row0 + (ai >> 1) * 128 + ((ai & 1) * 2 + m) * 16);
#pragma unroll
                for (int bj = 0; bj < 2; ++bj) {
                    const u32x4 yb = ybv[m][bj], gb = gbv[m][bj];
                    f32x2v o2[4];
#pragma unroll
                    for (int w = 0; w < 4; ++w) {
                        const f32x4 a4 = acc[ai >> 1][bj][(ai & 1) * 2 + m][w >> 1], b4 = bv[bj][w >> 1];
                        const f32x2v t = ((f32x2v){a4[(w & 1) * 2], a4[(w & 1) * 2 + 1]} + (f32x2v){b4[(w & 1) * 2], b4[(w & 1) * 2 + 1]}) * -1.44269504f;
                        f32x2v e; e.x = __builtin_amdgcn_exp2f(t.x); e.y = __builtin_amdgcn_exp2f(t.y);
                        const f32x2v d = e + 1.0f;
                        f32x2v r; r.x = __builtin_amdgcn_rcpf(d.x); r.y = __builtin_amdgcn_rcpf(d.y);
                        o2[w] = ((f32x2v){bflo(yb[w]), bfhi(yb[w])} * (f32x2v){bflo(gb[w]), bfhi(gb[w])}) * r;
                    }
                    u32x4 wv; wv.x = cvt_pk_bf16(o2[0].x, o2[0].y); wv.y = cvt_pk_bf16(o2[1].x, o2[1].y); wv.z = cvt_pk_bf16(o2[2].x, o2[2].y); wv.w = cvt_pk_bf16(o2[3].x, o2[3].y);
                    *(u32x4*)(MIX + row * 4096 + 2048 + col0 + bj * 128) = wv;
                }
            }
        }
    }
};
struct EpiOut {
    static constexpr bool PERM = false, AFTER_DRAIN = false;
    const float* xp; const float* xs; float* out; float* part; int tu;
    __device__ __forceinline__ void operator()(const f32x4 (&acc)[2][2][4][2], const Unit& u, int wr, int wc, int fr, int fq) const {
        const int row0 = u.pm * 256 + wr * 64 + fr, col0 = u.pn * 256 + wc * 32 + 4 * fq;
        const float* xb = (u.pm < 32) ? xp : xs - (size_t)NTOK_P * 2048;
        const bool split = (u.nkt != 64);
        if (!split) {
#pragma unroll
            for (int a4 = 0; a4 < 4; ++a4) {
                const int ai = a4 >> 1, m0 = (a4 & 1) * 2;
                f32x4 xv[2][2][2];
#pragma unroll
                for (int m = 0; m < 2; ++m)
#pragma unroll
                    for (int bj = 0; bj < 2; ++bj)
#pragma unroll
                        for (int n = 0; n < 2; ++n) xv[m][bj][n] = *(const f32x4*)(xb + (size_t)(row0 + ai * 128 + (m0 + m) * 16) * 2048 + col0 + bj * 128 + n * 16);
#pragma unroll
                for (int m = 0; m < 2; ++m)
#pragma unroll
                    for (int bj = 0; bj < 2; ++bj)
#pragma unroll
                        for (int n = 0; n < 2; ++n) *(f32x4*)(out + (size_t)(row0 + ai * 128 + (m0 + m) * 16) * 2048 + col0 + bj * 128 + n * 16) = xv[m][bj][n] + acc[ai][bj][m0 + m][n];
            }
        } else {
            float* pt = part + ((size_t)(u.k0 / (u.nkt * 64)) * 32 + tu) * 65536 + (size_t)(wr * 64 + fr) * 256 + wc * 32 + 4 * fq;
#pragma unroll
            for (int ai = 0; ai < 2; ++ai)
#pragma unroll
                for (int m = 0; m < 4; ++m)
#pragma unroll
                    for (int bj = 0; bj < 2; ++bj)
#pragma unroll
                        for (int n = 0; n < 2; ++n) *(f32x4*)(pt + (size_t)(ai * 128 + m * 16) * 256 + bj * 128 + n * 16) = acc[ai][bj][m][n];
        }
    }
};

struct OutOrder {
    int c;
    __device__ __forceinline__ bool next(int i, Unit& u) const {
        const int j = c >> 3, x = c & 7; const bool first = (i == 0);
        u.pm = first ? 32 + (j >> 3) : 4 * x + (j >> 3); u.pn = j & 7; u.k0 = first ? x * 512 : 0; u.nkt = first ? 8 : 64;
        return i < 2;
    }
    __device__ __forceinline__ void a_ready(const Unit&) const {}
    __device__ __forceinline__ void done(const Unit&) const {}
};
struct EpiOutF {
    static constexpr bool PERM = false, AFTER_DRAIN = true;
    const float* xp; float* out; const float* gfin; unsigned char* ws;
    __device__ __forceinline__ void operator()(const f32x4 (&acc)[2][2][4][2], const Unit& u, int wr, int wc, int fr, int fq) const {
        const int tu = (u.pm - 32) * 8 + u.pn;
        bf16_t* pt = (bf16_t*)(ws + WS_PART) + ((size_t)(u.k0 / 512) * 32 + tu) * 65536 + (size_t)(wr * 64 + fr) * 256 + wc * 32 + 4 * fq;
#pragma unroll
        for (int ai = 0; ai < 2; ++ai)
#pragma unroll
            for (int m = 0; m < 4; ++m)
#pragma unroll
                for (int bj = 0; bj < 2; ++bj)
#pragma unroll
                    for (int n = 0; n < 2; ++n) { const f32x4 v = acc[ai][bj][m][n]; u32x2 w; w.x = cvt_pk_bf16(v[0], v[1]); w.y = cvt_pk_bf16(v[2], v[3]);
                        *(u32x2*)(pt + (size_t)(ai * 128 + m * 16) * 256 + bj * 128 + n * 16) = w; }
    }
    __device__ __forceinline__ void fused(f32x4 (&acc)[2][2][4][2], const Unit& u, int wr, int wc, int fr, int fq, PG8_LAS unsigned char* lds, int wid, int lane) const {
        PG8_LAS float* P = (PG8_LAS float*)lds;
        float* exch = (float*)(ws + WS_EXCH); unsigned* cnt = (unsigned*)(ws + WS_CNT2);
        PG8_LAS float* Sx = (PG8_LAS float*)(lds + 4096);
        const int row0 = u.pm * 256 + wr * 64 + fr, col0 = u.pn * 256 + wc * 32 + 4 * fq;
#pragma unroll
        for (int a8 = 0; a8 < 8; ++a8) {
            const int ai = a8 >> 2, m = a8 & 3;
            f32x4 xv[2][2];
#pragma unroll
            for (int bj = 0; bj < 2; ++bj)
#pragma unroll
                for (int n = 0; n < 2; ++n) xv[bj][n] = *(const f32x4*)(xp + (size_t)(row0 + ai * 128 + m * 16) * 2048 + col0 + bj * 128 + n * 16);
            float sq = 0.f;
#pragma unroll
            for (int bj = 0; bj < 2; ++bj)
#pragma unroll
                for (int n = 0; n < 2; ++n) { const f32x4 o = xv[bj][n] + acc[ai][bj][m][n]; acc[ai][bj][m][n] = o; sq += (o[0] * o[0] + o[1] * o[1]) + (o[2] * o[2] + o[3] * o[3]); }
            sq += __shfl_xor(sq, 16); sq += __shfl_xor(sq, 32);
            if (fq == 0) P[(ai * 128 + wr * 64 + m * 16 + fr) * 4 + wc] = sq;
        }
        asm volatile("s_waitcnt lgkmcnt(0)" ::: "memory"); __builtin_amdgcn_s_barrier(); asm volatile("" ::: "memory");
        const int tid = wid * 64 + lane;
        if (tid < 256) {
            const float t = (P[tid * 4 + 0] + P[tid * 4 + 1]) + (P[tid * 4 + 2] + P[tid * 4 + 3]);
            __hip_atomic_store(exch + ((size_t)(u.pm * 256 + tid) * 8 + u.pn), t, __ATOMIC_RELAXED, __HIP_MEMORY_SCOPE_AGENT);
            asm volatile("s_waitcnt vmcnt(0)" ::: "memory");
            if (lane == 0) __hip_atomic_fetch_add(cnt + 64 * u.pm, 1u, __ATOMIC_RELAXED, __HIP_MEMORY_SCOPE_AGENT);
        }
        if (wid == 0) {
            unsigned sp = 0;
            while ((unsigned)__builtin_amdgcn_readfirstlane(__hip_atomic_load(cnt + 64 * u.pm, __ATOMIC_RELAXED, __HIP_MEMORY_SCOPE_AGENT)) < 32u) { __builtin_amdgcn_s_sleep(2); if (++sp > (1u << 22)) break; }
            __builtin_amdgcn_fence(__ATOMIC_ACQUIRE, "agent");
        }
        asm volatile("s_waitcnt vmcnt(0) lgkmcnt(0)" ::: "memory"); __builtin_amdgcn_s_barrier(); asm volatile("" ::: "memory");
        if (tid < 256) {
            const float* sl = exch + (size_t)(u.pm * 256 + tid) * 8; float t = 0.f;
#pragma unroll
            for (int q = 0; q < 8; ++q) t += __hip_atomic_load(sl + q, __ATOMIC_RELAXED, __HIP_MEMORY_SCOPE_AGENT);
            Sx[tid] = rsqrtf(t * (1.0f / 2048.0f) + EPS);
        }
        asm volatile("s_waitcnt lgkmcnt(0)" ::: "memory"); __builtin_amdgcn_s_barrier(); asm volatile("" ::: "memory");
        f32x4 gv[2][2];
#pragma unroll
        for (int bj = 0; bj < 2; ++bj)
#pragma unroll
            for (int n = 0; n < 2; ++n) gv[bj][n] = *(const f32x4*)(gfin + col0 + bj * 128 + n * 16);
#pragma unroll
        for (int ai = 0; ai < 2; ++ai)
#pragma unroll
            for (int m = 0; m < 4; ++m) {
                const int rl = ai * 128 + wr * 64 + m * 16 + fr; const float rs = Sx[rl];
#pragma unroll
                for (int bj = 0; bj < 2; ++bj)
#pragma unroll
                    for (int n = 0; n < 2; ++n) __builtin_nontemporal_store(acc[ai][bj][m][n] * rs * gv[bj][n], (f32x4*)(out + (size_t)(u.pm * 256 + rl) * 2048 + col0 + bj * 128 + n * 16));
            }
    }
};

__device__ __forceinline__ void glu_tail_reduce(const Params& p, const pg8::StaticOrder& S, int G) {
    const int tid = threadIdx.x, bid = blockIdx.x, tu = bid / S.nsplit, kc = bid % S.nsplit;
    unsigned* cnt = (unsigned*)(p.ws + WS_CNT) + tu * 64;
    if (tid == 0) {
        unsigned sp = 0;
        while (__hip_atomic_load(cnt, __ATOMIC_RELAXED, __HIP_MEMORY_SCOPE_AGENT) < (unsigned)S.nsplit * 8u) { __builtin_amdgcn_s_sleep(2); if (++sp > (1u << 22)) break; }
        __builtin_amdgcn_fence(__ATOMIC_ACQUIRE, "agent");
        asm volatile("s_waitcnt vmcnt(0)" ::: "memory");
    }
    __syncthreads();
    Unit u; S.map((S.nwg / G) * G + tu, u);
    const bf16_t* part = (const bf16_t*)(p.ws + WS_PART) + (size_t)tu * 65536;
    const bf16_t* YB = (const bf16_t*)(p.ws + WS_YB); const bf16_t* SGB = (const bf16_t*)(p.ws + WS_Z) + 4 * PLANE; bf16_t* MIX = (bf16_t*)(p.ws + WS_MIX);
    const int rl = kc * 32 + (tid >> 4), cl = (tid & 15) * 16;
    const size_t row = (size_t)(u.pm * 256 + rl); const int col = u.pn * 256 + cl;
    f32x4 a[4];
#pragma unroll
    for (int q = 0; q < 4; ++q) a[q] = *(const f32x4*)(p.b_glu + col + 4 * q);
    const int r_ai = rl >> 7, r_wr = (rl >> 6) & 1, r_m = (rl >> 4) & 3, r_fr = rl & 15, r_bj = cl >> 7, r_wc = (cl >> 5) & 3, r_fq0 = (cl >> 3) & 3;
    const size_t lidx = (size_t)((((r_wr * 4 + r_wc) * 2 + r_ai) * 4 + r_m) * 2 + r_bj) * 512 + (r_fq0 * 16 + r_fr) * 8;
#pragma unroll
    for (int c8 = 0; c8 < 8; ++c8)
#pragma unroll
        for (int q = 0; q < 2; ++q) { const u32x4 w = *(const u32x4*)(part + (size_t)c8 * 32 * 65536 + lidx + q * 128);
            a[2 * q] += (f32x4){bflo(w.x), bfhi(w.x), bflo(w.y), bfhi(w.y)}; a[2 * q + 1] += (f32x4){bflo(w.z), bfhi(w.z), bflo(w.w), bfhi(w.w)}; }
    u32x4 yb[2], gb[2], o[2];
#pragma unroll
    for (int q = 0; q < 2; ++q) { yb[q] = *(const u32x4*)(YB + row * 2048 + col + 8 * q); gb[q] = *(const u32x4*)(SGB + row * 2048 + col + 8 * q); }
#pragma unroll
    for (int q = 0; q < 2; ++q)
#pragma unroll
        for (int w = 0; w < 4; ++w) {
            const f32x4 av = a[2 * q + (w >> 1)];
            const float lo = bflo(yb[q][w]) * sigmoid_fast(av[(w & 1) * 2]) * bflo(gb[q][w]), hi = bfhi(yb[q][w]) * sigmoid_fast(av[(w & 1) * 2 + 1]) * bfhi(gb[q][w]);
            o[q][w] = cvt_pk_bf16(lo, hi);
        }
#pragma unroll
    for (int q = 0; q < 2; ++q) *(u32x4*)(MIX + row * 4096 + 2048 + col + 8 * q) = o[q];
}

__device__ __forceinline__ void sincos_d(double x, double& s, double& c) {
    const double q = rint(x * 0.6366197723675814);
    double r = fma(-q, 1.5707963267948966, x); r = fma(-q, 6.123233995736766e-17, r);
    const int qi = (int)q; const double r2 = r * r;
    const double sp = r * (1.0 + r2 * (-1.0 / 6 + r2 * (1.0 / 120 + r2 * (-1.0 / 5040 + r2 * (1.0 / 362880 + r2 * (-1.0 / 39916800 + r2 * (1.0 / 6227020800.0)))))));
    const double cp = 1.0 + r2 * (-0.5 + r2 * (1.0 / 24 + r2 * (-1.0 / 720 + r2 * (1.0 / 40320 + r2 * (-1.0 / 3628800 + r2 * (1.0 / 479001600 + r2 * (-1.0 / 87178291200.0)))))));
    const int k = qi & 3;
    s = (k == 0) ? sp : (k == 1) ? cp : (k == 2) ? -sp : -cp;
    c = (k == 0) ? cp : (k == 1) ? -sp : (k == 2) ? -cp : sp;
}
__device__ __forceinline__ double exp_d(double x) {
    const double k = rint(x * 1.4426950408889634);
    double r = fma(-k, 0.6931471805599453, x); r = fma(-k, 2.3190468138462996e-17, r);
    double p = 1.0 / 479001600;
    p = p * r + 1.0 / 39916800; p = p * r + 1.0 / 3628800; p = p * r + 1.0 / 362880; p = p * r + 1.0 / 40320; p = p * r + 1.0 / 5040; p = p * r + 1.0 / 720;
    p = p * r + 1.0 / 120; p = p * r + 1.0 / 24; p = p * r + 1.0 / 6; p = p * r + 0.5; p = p * r + 1.0; p = p * r + 1.0;
    return __builtin_ldexp(p, (int)k);
}

__device__ __forceinline__ void transpose_tiles(const Params& p, LAS unsigned char* lds, int t0, int t1, int start, int stride) {
    const int tid = threadIdx.x; unsigned char* ws = p.ws;
    LAS float* tile = (LAS float*)lds;
    constexpr int TS = 260;
    f32x4 r[8]; float sc[8];
    auto tile_of = [&](int t, const float*& src, bf16_t*& dst, int& K, int& N, int& kt, int& nt, const float*& gk) {
        int tl; gk = nullptr;
        if (t < 1280) { src = p.w_in; dst = (bf16_t*)(ws + WS_WINT); K = 2048; N = 10240; tl = t; gk = p.g_norm; }
        else if (t < 1536) { src = p.w_glu; dst = (bf16_t*)(ws + WS_WGLU); K = 2048; N = 2048; tl = t - 1280; }
        else { src = p.w_out; dst = (bf16_t*)(ws + WS_WOUT); K = 4096; N = 2048; tl = t - 1536; }
        const int tn = N / 256; kt = tl / tn; nt = tl % tn; };
    auto load_tile = [&](int t) {
        const float* src; bf16_t* dst; int K, N, kt, nt; const float* gk; tile_of(t, src, dst, K, N, kt, nt, gk);
#pragma unroll
        for (int i = 0; i < 8; ++i) { const int k = (tid >> 6) + 8 * i;
            r[i] = __builtin_nontemporal_load((const f32x4*)(src + (size_t)(kt * 64 + k) * N + nt * 256 + (tid & 63) * 4)); sc[i] = gk ? gk[kt * 64 + k] : 1.0f; } };
    int t = t0 + start;
    if (t < t1) load_tile(t);
    for (; t < t1; t += stride) {
        const float* src; bf16_t* dst; int K, N, kt, nt; const float* gk; tile_of(t, src, dst, K, N, kt, nt, gk);
#pragma unroll
        for (int i = 0; i < 8; ++i) { const int k = (tid >> 6) + 8 * i; *(LAS f32x4*)(tile + k * TS + (tid & 63) * 4) = r[i] * sc[i]; }
        __syncthreads();
        if (t + stride < t1) load_tile(t + stride);
        {
            const int n = tid >> 1, kh = (tid & 1) * 32; float v[32];
#pragma unroll
            for (int j = 0; j < 32; ++j) v[j] = tile[(kh + j) * TS + n];
            int nrow = nt * 256 + n;
            if (t < 1280) {
                if (nrow < 2048) nrow = (nrow >> 7) * 256 + (nrow & 127);
                else if (nrow < 4096) nrow += 2048;
                else if (nrow < 6144) { const int c = nrow - 4096; nrow = (c >> 7) * 256 + 128 + (c & 127); }
            }
            bf16_t* dp = dst + (size_t)nrow * K + kt * 64 + kh;
#pragma unroll
            for (int q = 0; q < 4; ++q) { u32x4 w; w.x = cvt_pk_bf16(v[8 * q], v[8 * q + 1]); w.y = cvt_pk_bf16(v[8 * q + 2], v[8 * q + 3]); w.z = cvt_pk_bf16(v[8 * q + 4], v[8 * q + 5]); w.w = cvt_pk_bf16(v[8 * q + 6], v[8 * q + 7]);
                *(u32x4*)(dp + 8 * q) = w; }
        }
        __syncthreads();
    }
}
__device__ __forceinline__ void build_tables(const Params& p, int gt, int GS, int G) {
    unsigned char* ws = p.ws;
    float* lam = (float*)(ws + WS_LAM); bf16_t* Bt = (bf16_t*)(ws + WS_BT); bf16_t* Ct = (bf16_t*)(ws + WS_CT); bf16_t* W16 = (bf16_t*)(ws + WS_WS16);
    for (int idx = gt; idx < 131072; idx += GS) {
        const int c = idx & 15, gp = idx >> 4, g = gp >> 6, pp = gp & 63;
        const double dt = exp_d((double)p.log_dt[g]), are = (double)p.a_re[gp], aim = (double)p.a_im[gp];
        const double mag = exp_d(are * dt); double sn, cs; sincos_d(aim * dt, sn, cs);
        const double lr = mag * cs, li = mag * sn;
        if (c == 0) { lam[gp * 2] = (float)lr; lam[gp * 2 + 1] = (float)li; }
        const double den = are * are + aim * aim, nr = lr - 1.0, ni = li;
        const double fr_ = (nr * are + ni * aim) / den, fi_ = (ni * are - nr * aim) / den;
        const double br = (double)p.b_re[idx], bi = (double)p.b_im[idx];
        const unsigned w = cvt_pk_bf16((float)(fr_ * br - fi_ * bi), (float)(fr_ * bi + fi_ * br));
        Bt[((size_t)g * 128 + 2 * pp) * 16 + c] = (bf16_t)(w & 0xffffu); Bt[((size_t)g * 128 + 2 * pp + 1) * 16 + c] = (bf16_t)(w >> 16);
    }
    for (int idx = gt; idx < 131072; idx += GS) {
        const int pp = idx & 63, gc = idx >> 6;
        *(unsigned*)(Ct + (size_t)gc * 128 + 2 * pp) = cvt_pk_bf16(p.c_re[idx], -p.c_im[idx]);
        const int s_ = idx & 127, tt = (idx >> 7) & 127;
        W16[idx] = (bf16_t)(cvt_pk_bf16(s_ <= tt ? p.w_s[idx] : 0.0f, 0.0f) & 0xffffu);
    }
    if (gt < 288) { pg8::StaticOrder S; S.init(NTOK, 2048, 4096, G, 0, 8); int v = -1;
        if (S.split_active()) { const int base = (S.nwg / G) * G; for (int t = 0; t < S.nwg - base; ++t) { Unit u; S.map(base + t, u); if (u.pm * 8 + u.pn == gt) v = t; } }
        ((int*)(ws + WS_TAB))[gt] = v; }
}
__device__ __forceinline__ int inproj_rem(int G) { return 1440 % G; }

__device__ __forceinline__ void phase0(const Params& p, LAS unsigned char* lds) {
    const int tid = threadIdx.x, G = gridDim.x, bid = blockIdx.x, wid = tid >> 6, lane = tid & 63;
    unsigned char* ws = p.ws;
    if (bid == 0) { for (int i = tid; i < 32 * 64; i += 512) ((unsigned*)(ws + WS_CNT))[i] = 0u; for (int i = tid; i < 36 * 64; i += 512) ((unsigned*)(ws + WS_CNT2))[i] = 0u; }
    transpose_tiles(p, lds, 0, 1280, bid, G);
    {
        bf16_t* X16 = (bf16_t*)(ws + WS_X16); float* rscale = (float*)(ws + WS_RSCALE);
        for (int row = bid * 8 + wid; row < NTOK; row += G * 8) {
            const float* xr = (row < NTOK_P) ? p.xp + (size_t)row * 2048 : p.xs + (size_t)(row - NTOK_P) * 2048;
            f32x4 v[8]; float ss = 0.f;
#pragma unroll
            for (int i = 0; i < 8; ++i) { v[i] = __builtin_nontemporal_load((const f32x4*)(xr + i * 256 + lane * 4)); ss += (v[i][0] * v[i][0] + v[i][1] * v[i][1]) + (v[i][2] * v[i][2] + v[i][3] * v[i][3]); }
            ss = wave_sum(ss);
            const float rs = rsqrtf(ss * (1.0f / 2048.0f) + EPS);
#pragma unroll
            for (int i = 0; i < 8; ++i) { u32x2 w; w.x = cvt_pk_bf16(v[i][0] * rs, v[i][1] * rs); w.y = cvt_pk_bf16(v[i][2] * rs, v[i][3] * rs); *(u32x2*)(X16 + (size_t)row * 2048 + i * 256 + lane * 4) = w; }
            if (lane == 0) rscale[row] = rs;
        }
    }
    if (inproj_rem(G) == 0) { transpose_tiles(p, lds, 1280, 2048, bid, G); build_tables(p, bid * 512 + tid, G * 512, G); }
}

__device__ __forceinline__ void spatial_units(const Params& p, LAS unsigned char* lds, int first, int stride) {
    const int tid = threadIdx.x, wid = __builtin_amdgcn_readfirstlane(tid >> 6), lane = tid & 63, fr = lane & 15, fq = lane >> 4;
    const bf16_t* Z = (const bf16_t*)(p.ws + WS_Z); const bf16_t* U = Z; const bf16_t* V = Z + PLANE; const bf16_t* GA = Z + 2 * PLANE;
    bf16_t* MIX = (bf16_t*)(p.ws + WS_MIX);
    constexpr int VS = 272, WOFF = 256 * VS;
    const int wr = wid >> 2, wc = wid & 3;
    const int pair = tid >> 3, oct = tid & 7, s0 = pair * 2;
    u32x4 r0[4], r1[4];
    int hcur = -1;
    if (first < 512) { const int h = first & 7, row0 = (first >> 3) * 128;
#pragma unroll
        for (int i = 0; i < 4; ++i) { const int pc = oct + 8 * i;
            r0[i] = __builtin_nontemporal_load((const u32x4*)(V + (size_t)(row0 + s0) * 2048 + h * 256 + pc * 8)); r1[i] = __builtin_nontemporal_load((const u32x4*)(V + (size_t)(row0 + s0 + 1) * 2048 + h * 256 + pc * 8)); } }
    for (int uid = first; uid < 512; uid += stride) {
        const int h = uid & 7, row0 = (uid >> 3) * 128;
        if (h != hcur) {
            const bf16_t* W = (const bf16_t*)(p.ws + WS_WS16) + (size_t)h * 16384;
#pragma unroll
            for (int i = 0; i < 4; ++i) { const int row = tid >> 2, piece = (tid & 3) + 4 * i; *(LAS u32x4*)(lds + WOFF + row * VS + piece * 16) = *(const u32x4*)(W + row * 128 + piece * 8); }
            hcur = h;
        }
        {
            float ss0 = 0.f, ss1 = 0.f;
#pragma unroll
            for (int i = 0; i < 4; ++i)
#pragma unroll
                for (int w = 0; w < 4; ++w) { const float a = bflo(r0[i][w]), b = bfhi(r0[i][w]), c = bflo(r1[i][w]), d = bfhi(r1[i][w]); ss0 += a * a + b * b; ss1 += c * c + d * d; }
            ss0 += __shfl_xor(ss0, 1); ss0 += __shfl_xor(ss0, 2); ss0 += __shfl_xor(ss0, 4);
            ss1 += __shfl_xor(ss1, 1); ss1 += __shfl_xor(ss1, 2); ss1 += __shfl_xor(ss1, 4);
            const float rs0 = rsqrtf(ss0 * (1.0f / 256.0f) + EPS), rs1 = rsqrtf(ss1 * (1.0f / 256.0f) + EPS);
#pragma unroll
            for (int i = 0; i < 4; ++i) { const int pc = oct + 8 * i;
                const f32x4 g0 = *(const f32x4*)(p.g_v + h * 256 + pc * 8), g1 = *(const f32x4*)(p.g_v + h * 256 + pc * 8 + 4);
#pragma unroll
                for (int w = 0; w < 4; ++w) {
                    const float ga = (w < 2) ? g0[2 * w] : g1[2 * w - 4], gb = (w < 2) ? g0[2 * w + 1] : g1[2 * w - 3];
                    const int d = pc * 8 + 2 * w;
                    *(LAS unsigned*)(lds + d * VS + s0 * 2) = cvt_pk_bf16(bflo(r0[i][w]) * rs0 * ga, bflo(r1[i][w]) * rs1 * ga);
                    *(LAS unsigned*)(lds + (d + 1) * VS + s0 * 2) = cvt_pk_bf16(bfhi(r0[i][w]) * rs0 * gb, bfhi(r1[i][w]) * rs1 * gb);
                }
            }
        }
        __syncthreads();
        if (uid + stride < 512) { const int un = uid + stride, hn = un & 7, rn = (un >> 3) * 128;
#pragma unroll
            for (int i = 0; i < 4; ++i) { const int pc = oct + 8 * i;
                r0[i] = __builtin_nontemporal_load((const u32x4*)(V + (size_t)(rn + s0) * 2048 + hn * 256 + pc * 8)); r1[i] = __builtin_nontemporal_load((const u32x4*)(V + (size_t)(rn + s0 + 1) * 2048 + hn * 256 + pc * 8)); } }
        float bsv[4];
#pragma unroll
        for (int mt = 0; mt < 4; ++mt) bsv[mt] = p.b_s[h * 128 + wr * 64 + mt * 16 + fr];
        f32x4 acc[4][4];
#pragma unroll
        for (int a = 0; a < 4; ++a)
#pragma unroll
            for (int b = 0; b < 4; ++b) acc[a][b] = (f32x4){0.f, 0.f, 0.f, 0.f};
#pragma unroll
        for (int kt = 0; kt < 4; ++kt) {
            if (32 * kt <= wr * 64 + 63) {
                bf16x8 wf[4], vf[4];
#pragma unroll
                for (int mt = 0; mt < 4; ++mt) wf[mt] = *(const LAS bf16x8*)(lds + WOFF + (wr * 64 + mt * 16 + fr) * VS + (32 * kt + 8 * fq) * 2);
#pragma unroll
                for (int nt = 0; nt < 4; ++nt) vf[nt] = *(const LAS bf16x8*)(lds + (wc * 64 + nt * 16 + fr) * VS + (32 * kt + 8 * fq) * 2);
#pragma unroll
                for (int mt = 0; mt < 4; ++mt)
#pragma unroll
                    for (int nt = 0; nt < 4; ++nt) acc[mt][nt] = __builtin_amdgcn_mfma_f32_16x16x32_bf16(vf[nt], wf[mt], acc[mt][nt], 0, 0, 0);
            }
        }
#pragma unroll
        for (int mt = 0; mt < 4; ++mt) {
            const int t = wr * 64 + mt * 16 + fr; const size_t row = (size_t)(row0 + t); const float bs = bsv[mt];
            u32x2 uu[4];
#pragma unroll
            for (int nt = 0; nt < 4; ++nt) { const int d0 = h * 256 + wc * 64 + nt * 16 + 4 * fq; uu[nt] = *(const u32x2*)(U + row * 2048 + d0); }
#pragma unroll
            for (int nt = 0; nt < 4; ++nt) {
                const int d0 = h * 256 + wc * 64 + nt * 16 + 4 * fq;
                const u32x2 u2 = uu[nt];
                u32x2 o;
                o.x = cvt_pk_bf16(bflo(u2.x) * (acc[mt][nt][0] + bs), bfhi(u2.x) * (acc[mt][nt][1] + bs));
                o.y = cvt_pk_bf16(bflo(u2.y) * (acc[mt][nt][2] + bs), bfhi(u2.y) * (acc[mt][nt][3] + bs));
                *(u32x2*)(MIX + row * 4096 + d0) = o;
            }
        }
        __syncthreads();
    }
}

__device__ __forceinline__ void spatial_sample_task(const Params& p, int seq, int h, int lane) {
    const bf16_t* Z = (const bf16_t*)(p.ws + WS_Z); const bf16_t* U = Z; const bf16_t* V = Z + PLANE; const bf16_t* GA = Z + 2 * PLANE;
    bf16_t* MIX = (bf16_t*)(p.ws + WS_MIX);
    const int c0 = h * 256 + lane * 4;
    const f32x4 gv = *(const f32x4*)(p.g_v + c0);
    f32x4 vn[8];
#pragma unroll
    for (int j = 0; j < 8; ++j) {
        const size_t row = (size_t)(NTOK_P + seq * 8 + j);
        const u32x2 r = *(const u32x2*)(V + row * 2048 + c0);
        f32x4 x = (f32x4){bflo(r.x), bfhi(r.x), bflo(r.y), bfhi(r.y)};
        const float ss = wave_sum((x[0] * x[0] + x[1] * x[1]) + (x[2] * x[2] + x[3] * x[3]));
        const float rs = rsqrtf(ss * (1.0f / 256.0f) + EPS);
        vn[j] = x * rs * gv;
        __builtin_nontemporal_store(vn[j], (f32x4*)(p.out + O_V + (size_t)(seq * 8 + j) * 2048 + c0));
    }
#pragma unroll
    for (int t = 0; t < 8; ++t) {
        const float bs = p.b_s[h * 128 + t];
        f32x4 m = (f32x4){bs, bs, bs, bs};
#pragma unroll
        for (int s = 0; s <= t; ++s) m += p.w_s[(size_t)(h * 128 + t) * 128 + s] * vn[s];
        const size_t row = (size_t)(NTOK_P + seq * 8 + t);
        const u32x2 uu = *(const u32x2*)(U + row * 2048 + c0);
        u32x2 o;
        o.x = cvt_pk_bf16(bflo(uu.x) * m[0], bfhi(uu.x) * m[1]);
        o.y = cvt_pk_bf16(bflo(uu.y) * m[2], bfhi(uu.y) * m[3]);
        *(u32x2*)(MIX + row * 4096 + c0) = o;
    }
}

__device__ __forceinline__ void s5_task(const Params& p, LAS unsigned char* wl, int task, int lane) {
    const bool sample = task >= 512;
    const int g = task & 127;
    int row0, ntiles, seq0 = 0; float* ore; float* oim;
    if (!sample) { const int b = task >> 7; row0 = b * 2048; ntiles = 64; ore = p.out + O_RE_P + (size_t)(b * 128 + g) * 64; oim = p.out + O_IM_P + (size_t)(b * 128 + g) * 64; }
    else { const int tb = (task - 512) >> 7; row0 = NTOK_P + tb * 256; ntiles = 8; seq0 = tb * 32; ore = p.out + O_RE_S + (size_t)g * 64; oim = p.out + O_IM_S + (size_t)g * 64; }
    const int r = lane & 31, hh = lane >> 5, fr = lane & 15, fq = lane >> 4;
    const float* lam = (const float*)(p.ws + WS_LAM);
    const float lr = lam[(g * 64 + lane) * 2], li = lam[(g * 64 + lane) * 2 + 1];
    const bf16_t* Bt = (const bf16_t*)(p.ws + WS_BT); const bf16_t* Ct = (const bf16_t*)(p.ws + WS_CT);
    bf16x8 btf[4], ctf[4];
#pragma unroll
    for (int mt = 0; mt < 4; ++mt) btf[mt] = *(const bf16x8*)(Bt + ((size_t)(g * 128 + 32 * mt + r) * 16 + 8 * hh));
#pragma unroll
    for (int kt = 0; kt < 4; ++kt) ctf[kt] = *(const bf16x8*)(Ct + ((size_t)(g * 16 + fr) * 128 + 32 * kt + 8 * fq));
    const f32x4 dsk = *(const f32x4*)(p.d_skip + g * 16 + 4 * fq);
    const bf16_t* XB = (const bf16_t*)(p.ws + WS_Z) + 3 * PLANE; bf16_t* YB = (bf16_t*)(p.ws + WS_YB);
    float hre = 0.f, him = 0.f;
    bf16x8 uf = *(const bf16x8*)(XB + (size_t)(row0 + r) * 2048 + g * 16 + 8 * hh);
    u32x2 ue0 = *(const u32x2*)(XB + (size_t)(row0 + fr) * 2048 + g * 16 + 4 * fq), ue1 = *(const u32x2*)(XB + (size_t)(row0 + 16 + fr) * 2048 + g * 16 + 4 * fq);
    for (int ti = 0; ti < ntiles; ++ti) {
        const int R = row0 + 32 * ti;
        float h0r[4] = {0.f, 0.f, 0.f, 0.f}, h0i[4] = {0.f, 0.f, 0.f, 0.f};
        if (sample) {
#pragma unroll
            for (int q = 0; q < 4; ++q) { const size_t o = ((size_t)(seq0 + ti * 4 + q) * 128 + g) * 64 + lane; h0r[q] = p.sre[o]; h0i[q] = p.sim[o]; }
        }
#pragma unroll
        for (int mt = 0; mt < 4; ++mt) {
            f32x16 a = {0.f, 0.f, 0.f, 0.f, 0.f, 0.f, 0.f, 0.f, 0.f, 0.f, 0.f, 0.f, 0.f, 0.f, 0.f, 0.f};
            a = __builtin_amdgcn_mfma_f32_32x32x16_bf16(btf[mt], uf, a, 0, 0, 0);
#pragma unroll
            for (int i = 0; i < 4; ++i) *(LAS f32x4*)(wl + r * S5_ROWB + (32 * mt + 8 * i + 4 * hh) * 4) = (f32x4){a[4 * i], a[4 * i + 1], a[4 * i + 2], a[4 * i + 3]};
        }
        const u32x2 uc0 = ue0, uc1 = ue1;
        if (ti + 1 < ntiles) {
            uf = *(const bf16x8*)(XB + (size_t)(R + 32 + r) * 2048 + g * 16 + 8 * hh);
            ue0 = *(const u32x2*)(XB + (size_t)(R + 32 + fr) * 2048 + g * 16 + 4 * fq); ue1 = *(const u32x2*)(XB + (size_t)(R + 48 + fr) * 2048 + g * 16 + 4 * fq);
        }
        WAVE_ORDER();
        f32x2v buv[32];
#pragma unroll
        for (int t = 0; t < 32; ++t) buv[t] = *(const LAS f32x2v*)(wl + t * S5_ROWB + lane * 8);
#pragma unroll
        for (int t = 0; t < 32; ++t) {
            if (sample && (t & 7) == 0) { hre = h0r[t >> 3]; him = h0i[t >> 3]; }
            const f32x2v bu = buv[t];
            float nre = fmaf(lr, hre, bu.x); nre = fmaf(-li, him, nre);
            float nim = fmaf(lr, him, bu.y); nim = fmaf(li, hre, nim);
            hre = nre; him = nim;
            *(LAS unsigned*)(wl + t * S5_ROWB + lane * 4) = cvt_pk_bf16(hre, him);
            if (sample && (t & 7) == 7) { const size_t o = (size_t)(seq0 + ti * 4 + (t >> 3)) * 8192 + lane; ore[o] = hre; oim[o] = him; }
        }
        WAVE_ORDER();
#pragma unroll
        for (int mt2 = 0; mt2 < 2; ++mt2) {
            f32x4 a2 = (f32x4){0.f, 0.f, 0.f, 0.f};
#pragma unroll
            for (int kt = 0; kt < 4; ++kt) {
                const bf16x8 hf = *(const LAS bf16x8*)(wl + (16 * mt2 + fr) * S5_ROWB + (32 * kt + 8 * fq) * 2);
                a2 = __builtin_amdgcn_mfma_f32_16x16x32_bf16(ctf[kt], hf, a2, 0, 0, 0);
            }
            const u32x2 uc = mt2 ? uc1 : uc0;
            const f32x2v ya = act_pk((f32x2v){a2[0], a2[1]} + (f32x2v){dsk[0], dsk[1]} * (f32x2v){bflo(uc.x), bfhi(uc.x)}, -1.44269504f * 1.5957691216f, -1.44269504f * 0.0713548163f);
            const f32x2v yb2 = act_pk((f32x2v){a2[2], a2[3]} + (f32x2v){dsk[2], dsk[3]} * (f32x2v){bflo(uc.y), bfhi(uc.y)}, -1.44269504f * 1.5957691216f, -1.44269504f * 0.0713548163f);
            u32x2 o; o.x = cvt_pk_bf16(ya.x, ya.y); o.y = cvt_pk_bf16(yb2.x, yb2.y);
            *(u32x2*)(YB + (size_t)(R + 16 * mt2 + fr) * 2048 + g * 16 + 4 * fq) = o;
        }
        WAVE_ORDER();
    }
    if (!sample) { ore[lane] = hre; oim[lane] = him; }
}

__device__ __forceinline__ void phase2(const Params& p, LAS unsigned char* lds) {
    const int tid = threadIdx.x, G = gridDim.x, bid = blockIdx.x, wid = __builtin_amdgcn_readfirstlane(tid >> 6), lane = tid & 63;
    const int nS5 = G / 2;
    LAS unsigned char* wl = lds + wid * S5_WAVE_B;
    if (bid < nS5) {
        if (wid < 4) { for (int t = bid * 4 + wid; t < 512; t += nS5 * 4) s5_task(p, wl, t, lane); }
        else { for (int t = bid * 4 + (wid - 4); t < 1024; t += nS5 * 4) spatial_sample_task(p, t >> 3, t & 7, lane); }
    } else {
        const int nA = G - nS5, ba = bid - nS5;
        if (wid < 4) { for (int t = 512 + ba * 4 + wid; t < 1024; t += nA * 4) s5_task(p, wl, t, lane); }
        __syncthreads();
        spatial_units(p, lds, ba, nA);
    }
}

__global__ void __launch_bounds__(512, 2) hymba_fwd(Params p) {
    extern __shared__ __attribute__((aligned(16))) unsigned char smem[];
    LAS unsigned char* lds = (LAS unsigned char*)smem;
    cg::grid_group grid = cg::this_grid();
    if (p.ws == nullptr) grid.sync();
    if (threadIdx.x < 4) ((LAS unsigned*)(lds + LDS_MAIN))[threadIdx.x] = 0u;
    __syncthreads();
    XcdBarrier bar = xcd_barrier_post((unsigned*)(p.ws + WS_BAR), (volatile LAS unsigned*)(lds + LDS_MAIN));
    const int G = gridDim.x, bid = blockIdx.x;
    unsigned char* ws = p.ws;
    bf16_t* Z = (bf16_t*)(ws + WS_Z);

    for (int rep = 0; rep < REP0; ++rep) phase0(p, lds);
    xcd_barrier(bar);
    {
        pg8::Gemm g{(const bf16_t*)(ws + WS_X16), (const bf16_t*)(ws + WS_WINT), NTOK, 10240, 2048};
        pg8::StaticOrder S; S.init(NTOK, 10240, 2048, G, bid);
        EpiInProj E{Z, (const float*)(ws + WS_RSCALE)};
        pg8::gemm_phase<EpiInProj, pg8::StaticOrder>(lds, g, S, E);
    }
    { const int rem = inproj_rem(G);
      if (rem != 0 && bid >= rem) { transpose_tiles(p, lds, 1280, 2048, bid - rem, G - rem); build_tables(p, (bid - rem) * 512 + (int)threadIdx.x, (G - rem) * 512, G); } }
    xcd_barrier(bar);
    for (int rep = 0; rep < REP2; ++rep) phase2(p, lds);
    xcd_barrier(bar);
    {
        pg8::Gemm g{(const bf16_t*)(ws + WS_YB), (const bf16_t*)(ws + WS_WGLU), NTOK, 2048, 2048};
        pg8::StaticOrder S; S.init(NTOK, 2048, 2048, G, bid, 8);
        if (S.split_active()) S.cnt = (unsigned*)(ws + WS_CNT) + (bid / S.nsplit) * 64;
        EpiGlu E{(const bf16_t*)(ws + WS_YB), Z + 4 * PLANE, p.b_glu, (bf16_t*)(ws + WS_MIX), (float*)(ws + WS_PART), (S.split_active() ? bid / S.nsplit : 0)};
        pg8::gemm_phase<EpiGlu, pg8::StaticOrder>(lds, g, S, E);
        if (S.split_active()) glu_tail_reduce(p, S, G);
    }
    xcd_barrier(bar);
    if (G == 256) {
        {
            pg8::Gemm g{(const bf16_t*)(ws + WS_MIX), (const bf16_t*)(ws + WS_WOUT), NTOK, 2048, 4096};
            OutOrder S{bid};
            EpiOutF E{p.xp, p.out, p.g_final, ws};
            pg8::gemm_phase<EpiOutF, OutOrder>(lds, g, S, E);
        }
        xcd_barrier(bar);
        {
            const int tid = threadIdx.x, wid = tid >> 6, lane = tid & 63, rsub = wid >> 1, half = wid & 1;
            const bf16_t* part = (const bf16_t*)(ws + WS_PART);
            LAS float* sx = (LAS float*)lds;
            for (int r0 = bid * 4; r0 < 1024; r0 += G * 4) {
                const int r = r0 + rsub;
                float* o = p.out + (size_t)(NTOK_P + r) * 2048; const float* xr = p.xs + (size_t)r * 2048;
                const int tub = (r >> 8) * 8 + half * 4;
                f32x4 a[4]; u32x2 q[4][8];
#pragma unroll
                for (int i = 0; i < 4; ++i) {
                    a[i] = __builtin_nontemporal_load((const f32x4*)(xr + (half * 4 + i) * 256 + lane * 4));
                    const bf16_t* pp = part + (size_t)(tub + i) * 65536 + (size_t)(r & 255) * 256 + lane * 4;
#pragma unroll
                    for (int kc = 0; kc < 8; ++kc) q[i][kc] = *(const u32x2*)(pp + (size_t)kc * 32 * 65536);
                }
                float ss = 0.f;
#pragma unroll
                for (int i = 0; i < 4; ++i) {
#pragma unroll
                    for (int kc = 0; kc < 8; ++kc) a[i] += (f32x4){bflo(q[i][kc].x), bfhi(q[i][kc].x), bflo(q[i][kc].y), bfhi(q[i][kc].y)};
                    ss += (a[i][0] * a[i][0] + a[i][1] * a[i][1]) + (a[i][2] * a[i][2] + a[i][3] * a[i][3]);
                }
                ss = wave_sum(ss);
                if (lane == 0) sx[wid] = ss;
                __syncthreads();
                const float rs = rsqrtf((sx[rsub * 2] + sx[rsub * 2 + 1]) * (1.0f / 2048.0f) + EPS);
#pragma unroll
                for (int i = 0; i < 4; ++i) { const f32x4 gf = *(const f32x4*)(p.g_final + (half * 4 + i) * 256 + lane * 4); __builtin_nontemporal_store(a[i] * rs * gf, (f32x4*)(o + (half * 4 + i) * 256 + lane * 4)); }
                __syncthreads();
            }
        }
    }
}

extern "C" void kernel_launch(void* const* d_in, const int* in_sizes, int n_in, void* d_out, int out_size, void* d_ws, size_t ws_size, hipStream_t stream) {
    static int grid_blocks = 0;
    if (grid_blocks == 0) {
        if (n_in != 21 || ws_size < WS_END) { fprintf(stderr, "kernel_launch: unexpected n_in %d / ws_size %zu (need %zu)\n", n_in, ws_size, (size_t)WS_END); grid_blocks = -1; return; }
        int dev = 0, cus = 0, per_cu = 0;
        hipGetDevice(&dev);
        hipDeviceGetAttribute(&cus, hipDeviceAttributeMultiprocessorCount, dev);
        if (hipFuncSetAttribute((const void*)hymba_fwd, hipFuncAttributeMaxDynamicSharedMemorySize, LDS_BYTES) != hipSuccess) { fprintf(stderr, "kernel_launch: hipFuncSetAttribute failed\n"); grid_blocks = -1; return; }
        if (hipOccupancyMaxActiveBlocksPerMultiprocessor(&per_cu, (const void*)hymba_fwd, 512, LDS_BYTES) != hipSuccess || per_cu < 1) { fprintf(stderr, "kernel_launch: occupancy query gave %d\n", per_cu); per_cu = 1; (void)hipGetLastError(); }
        grid_blocks = 256;
        if (cus != 256) fprintf(stderr, "kernel_launch: built for a 256-CU device, found %d CUs\n", cus);
    }
    if (grid_blocks < 0) return;
    if (hipMemsetAsync((char*)d_ws + WS_BAR, 0, 16384, stream) != hipSuccess) { fprintf(stderr, "kernel_launch: memset of the barrier words failed\n"); return; }
    Params p{};
    p.xp = (const float*)d_in[0]; p.xs = (const float*)d_in[1]; p.sre = (const float*)d_in[2]; p.sim = (const float*)d_in[3]; p.g_norm = (const float*)d_in[4];
    p.w_in = (const float*)d_in[5]; p.g_v = (const float*)d_in[6]; p.w_s = (const float*)d_in[7]; p.b_s = (const float*)d_in[8]; p.a_re = (const float*)d_in[9];
    p.a_im = (const float*)d_in[10]; p.log_dt = (const float*)d_in[11]; p.b_re = (const float*)d_in[12]; p.b_im = (const float*)d_in[13]; p.c_re = (const float*)d_in[14];
    p.c_im = (const float*)d_in[15]; p.d_skip = (const float*)d_in[16]; p.w_glu = (const float*)d_in[17]; p.b_glu = (const float*)d_in[18]; p.w_out = (const float*)d_in[19];
    p.g_final = (const float*)d_in[20]; p.out = (float*)d_out; p.ws = (unsigned char*)d_ws;
    void* args[] = {&p};
    hipError_t e = hipLaunchCooperativeKernel((const void*)hymba_fwd, dim3(grid_blocks), dim3(512), args, LDS_BYTES, stream);
    if (e != hipSuccess) fprintf(stderr, "cooperative launch failed: %s (grid %d)\n", hipGetErrorString(e), grid_blocks);
}
```

```cpp
#include <hip/hip_runtime.h>
#include <hip/hip_cooperative_groups.h>
#include <cstdio>
namespace cg = cooperative_groups;

namespace pg8 {
#define PG8_LAS __attribute__((address_space(3)))
typedef unsigned short bf16_t;
typedef short bf16x8 __attribute__((ext_vector_type(8)));
typedef float f32x4 __attribute__((ext_vector_type(4)));
typedef unsigned u32x4 __attribute__((ext_vector_type(4)));
constexpr int BM = 256, BK = 64, HALF = 128, HTB = HALF * BK * 2  , STAGE_BYTES = 8 * HTB, NXCD = 8, WGM = 8;

__host__ __device__ __forceinline__ int lds_byte(int r, int c) { const int st = (r >> 4) * 2 + (c >> 5), rr = r & 15, cc = c & 31, ob = rr * 64 + cc * 2; return st * 1024 + (ob ^ (((ob >> 9) & 1) << 5)); }
__host__ __device__ __forceinline__ void stage_rc(int b, int& R, int& C) { const int st = b / 1024, sb = b % 1024, swz = sb ^ (((sb >> 9) & 1) << 5); R = (st >> 1) * 16 + swz / 64; C = (st & 1) * 32 + (swz % 64) / 2; }
__host__ __device__ __forceinline__ int perm32(int rho) { const int n = rho >> 4, i = rho & 15; return 8 * (i >> 2) + 4 * n + (i & 3); }

struct Unit { int pm, pn, k0, nkt; };
struct Gemm { const bf16_t* A; const bf16_t* Bt; int M, N, K; };

struct StaticOrder {
    int nM, nN, nwg, G, c, nkt, nsplit; unsigned* cnt = nullptr;
    __host__ __device__ void init(int M, int N, int K, int G_, int c_, int nsplit_ = 1) { nM = M / BM; nN = N / BM; nwg = nM * nN; G = G_; c = c_; nkt = K / BK;
        nsplit = ((nwg % G) * nsplit_ == G && (nkt / nsplit_) >= 4 && (nkt % (2 * nsplit_)) == 0) ? nsplit_ : 1; }
    __host__ __device__ bool split_active() const { return nsplit > 1; }
    __host__ __device__ void map(int wgid, Unit& u) const {
        { const int q = nwg / NXCD, r = nwg % NXCD, xcd = wgid % NXCD, off = wgid / NXCD; wgid = (xcd < r ? xcd * (q + 1) : r * (q + 1) + (xcd - r) * q) + off; }
        const int nig = WGM * nN, gid = wgid / nig, fm = gid * WGM, gsz = (nM - fm) < WGM ? (nM - fm) : WGM;
        u.pm = fm + ((wgid % nig) % gsz); u.pn = (wgid % nig) / gsz; u.k0 = 0; u.nkt = nkt; }
    __host__ __device__ bool next(int i, Unit& u) const {
        const int full = nwg / G;
        if (nsplit > 1) {
            if (i < full) { map(i * G + c, u); return true; }
            if (i > full) { map(0, u); return false; }
            map(full * G + c / nsplit, u); u.nkt = nkt / nsplit; u.k0 = (c % nsplit) * u.nkt * BK; return true; }
        const long L = (long)i * G + c; if (L >= nwg) { map(0, u); return false; }
        map((int)L, u); return true;
    }
    __device__ __forceinline__ void a_ready(const Unit&) const {}
    __device__ __forceinline__ void done(const Unit& u) const {
        if (cnt != nullptr && u.nkt != nkt) { asm volatile("s_waitcnt vmcnt(0)" ::: "memory");
            if ((threadIdx.x & 63) == 0) __hip_atomic_fetch_add(cnt, 1u, __ATOMIC_RELAXED, __HIP_MEMORY_SCOPE_AGENT); } }
};
__device__ __forceinline__ unsigned cvt_pk_bf16(float lo, float hi) { unsigned r; asm("v_cvt_pk_bf16_f32 %0, %1, %2" : "=v"(r) : "v"(lo), "v"(hi)); return r; }
typedef float f32x2 __attribute__((ext_vector_type(2)));
template <class Epi, class Sched>
__device__ __forceinline__ void gemm_phase(PG8_LAS unsigned char* lds, const Gemm g, const Sched& S, const Epi& E) {
    const int tid = threadIdx.x, wid = __builtin_amdgcn_readfirstlane(tid >> 6), lane = tid & 63, wr = wid >> 2, wc = wid & 3, fr = lane & 15, fq = lane >> 4;
    const int K = g.K;
    unsigned voffA[2], voffB[2];
#pragma unroll
    for (int i = 0; i < 2; ++i) { int R, C; stage_rc(tid * 16 + i * 8192, R, C); const int Rb = Epi::PERM ? ((R & ~31) + perm32(R & 31)) : R;
        voffA[i] = (unsigned)(R * K + C) * 2u; voffB[i] = (unsigned)(Rb * K + C) * 2u; }
    const size_t kstep = (size_t)(BK * 2);
    const size_t hstep = (size_t)HALF * K * 2;
    const size_t tstep = 2 * hstep;
    const unsigned ldsw = (unsigned)wid * 1024u;
    const int aoff = lds_byte(wr * 64 + fr, fq * 8), boff = lds_byte(wc * 32 + fr, fq * 8);
#define PG8_SA(b, h) (((b) * 2 + (h)) * HTB)
#define PG8_SB(b, h) ((4 + (b) * 2 + (h)) * HTB)
#define PG8_STAGE(bufoff, gbase, voff) do { _Pragma("unroll") for (int _i = 0; _i < 2; ++_i) \
        __builtin_amdgcn_global_load_lds((const unsigned*)((const char*)(gbase) + (voff)[_i]), (PG8_LAS unsigned*)(lds + (bufoff) + ldsw + _i * 8192), 16, 0, 0); } while (0)
#define PG8_LDA(dst, b, h) do { _Pragma("unroll") for (int m = 0; m < 4; ++m) _Pragma("unroll") for (int k = 0; k < 2; ++k) dst[m][k] = *(const PG8_LAS bf16x8*)(lds + PG8_SA(b, h) + aoff + m * 2048 + k * 1024); } while (0)
#define PG8_LDB(dst, b, h) do { _Pragma("unroll") for (int n = 0; n < 2; ++n) _Pragma("unroll") for (int k = 0; k < 2; ++k) dst[n][k] = *(const PG8_LAS bf16x8*)(lds + PG8_SB(b, h) + boff + n * 2048 + k * 1024); } while (0)
#define PG8_MMA(ai, bj, At, Bt) do { __builtin_amdgcn_s_setprio(1); _Pragma("unroll") for (int m = 0; m < 4; ++m) _Pragma("unroll") for (int n = 0; n < 2; ++n) _Pragma("unroll") for (int k = 0; k < 2; ++k) \
        acc[ai][bj][m][n] = __builtin_amdgcn_mfma_f32_16x16x32_bf16(Bt[n][k], At[m][k], acc[ai][bj][m][n], 0, 0, 0); __builtin_amdgcn_s_setprio(0); } while (0)
#define PG8_WAIT_V(n) asm volatile("s_waitcnt vmcnt(" #n ")" ::: "memory")
#define PG8_WAIT_L(n) asm volatile("s_waitcnt lgkmcnt(" #n ")" ::: "memory")
#define PG8_BAR __builtin_amdgcn_s_barrier()
#define PG8_SCHED __builtin_amdgcn_sched_barrier(0)
    Unit cur, nxt; int ui = 0;
    if (!S.next(0, cur)) return;
    f32x4 acc[2][2][4][2];
#pragma unroll
    for (int a = 0; a < 2; ++a)
#pragma unroll
        for (int b = 0; b < 2; ++b)
#pragma unroll
            for (int m = 0; m < 4; ++m)
#pragma unroll
                for (int n = 0; n < 2; ++n) acc[a][b][m][n] = (f32x4){0.f, 0.f, 0.f, 0.f};
    bf16x8 At[4][2], B0[2][2], B1[2][2];
    const char* cA = (const char*)g.A + (size_t)cur.pm * tstep + (size_t)cur.k0 * 2; const char* cB = (const char*)g.Bt + (size_t)cur.pn * tstep + (size_t)cur.k0 * 2;
    S.a_ready(cur);
    PG8_STAGE(PG8_SB(0, 0), cB, voffB); PG8_STAGE(PG8_SA(0, 0), cA, voffA); PG8_STAGE(PG8_SB(0, 1), cB + hstep, voffB); PG8_STAGE(PG8_SA(0, 1), cA + hstep, voffA);
    if (wr == 1) PG8_BAR;
    PG8_WAIT_V(4); PG8_BAR;
    PG8_STAGE(PG8_SB(1, 0), cB + kstep, voffB); PG8_STAGE(PG8_SA(1, 0), cA + kstep, voffA); PG8_STAGE(PG8_SB(1, 1), cB + hstep + kstep, voffB);
    PG8_WAIT_V(6); PG8_BAR;
    for (;;) {
        const bool has_next = S.next(ui + 1, nxt);
        const char* nA = has_next ? (const char*)g.A + (size_t)nxt.pm * tstep + (size_t)nxt.k0 * 2 : cA; const char* nB = has_next ? (const char*)g.Bt + (size_t)nxt.pn * tstep + (size_t)nxt.k0 * 2 : cB;
        const int nt = cur.nkt;
        for (int t = 0; t < nt; t += 2) {
            const bool last = (t == nt - 2);
            const char* a1 = cA + (size_t)(t + 1) * kstep;
            const char* a2 = last ? nA : cA + (size_t)(t + 2) * kstep; const char* b2 = last ? nB : cB + (size_t)(t + 2) * kstep;
            const char* a3 = a2 + kstep; const char* b3 = b2 + kstep;
            if (last && has_next) S.a_ready(nxt);
            PG8_LDB(B0, 0, 0); PG8_SCHED; PG8_LDA(At, 0, 0); PG8_STAGE(PG8_SA(1, 1), a1 + hstep, voffA);
            PG8_WAIT_L(8); PG8_BAR; PG8_WAIT_L(0); PG8_MMA(0, 0, At, B0); PG8_BAR; PG8_SCHED;
            PG8_LDB(B1, 0, 1); PG8_STAGE(PG8_SB(0, 0), b2, voffB);
            PG8_BAR; PG8_WAIT_L(0); PG8_MMA(0, 1, At, B1); PG8_BAR;
            PG8_LDA(At, 0, 1); PG8_STAGE(PG8_SA(0, 0), a2, voffA);
            PG8_BAR; PG8_WAIT_L(0); PG8_MMA(1, 0, At, B0); PG8_BAR; PG8_SCHED;
            PG8_STAGE(PG8_SB(0, 1), b2 + hstep, voffB);
            PG8_WAIT_V(6); PG8_BAR; PG8_MMA(1, 1, At, B1); PG8_BAR;
            PG8_LDB(B0, 1, 0); PG8_SCHED; PG8_LDA(At, 1, 0); PG8_STAGE(PG8_SA(0, 1), a2 + hstep, voffA);
            PG8_WAIT_L(8); PG8_BAR; PG8_WAIT_L(0); PG8_MMA(0, 0, At, B0); PG8_BAR; PG8_SCHED;
            PG8_LDB(B1, 1, 1); PG8_STAGE(PG8_SB(1, 0), b3, voffB);
            PG8_BAR; PG8_WAIT_L(0); PG8_MMA(0, 1, At, B1); PG8_BAR;
            PG8_LDA(At, 1, 1); PG8_STAGE(PG8_SA(1, 0), a3, voffA);
            PG8_BAR; PG8_WAIT_L(0); PG8_MMA(1, 0, At, B0); PG8_BAR; PG8_SCHED;
            PG8_STAGE(PG8_SB(1, 1), b3 + hstep, voffB);
            PG8_WAIT_V(6); PG8_BAR; PG8_MMA(1, 1, At, B1); PG8_BAR;
        }
        if (!Epi::AFTER_DRAIN || has_next) { E(acc, cur, wr, wc, fr, fq); S.done(cur); }
        if (!has_next) break;
#pragma unroll
        for (int a = 0; a < 2; ++a)
#pragma unroll
            for (int b = 0; b < 2; ++b)
#pragma unroll
                for (int m = 0; m < 4; ++m)
#pragma unroll
                    for (int n = 0; n < 2; ++n) acc[a][b][m][n] = (f32x4){0.f, 0.f, 0.f, 0.f};
        cur = nxt; cA = nA; cB = nB; ++ui;
    }
    PG8_WAIT_V(0);
    if (wr == 0) PG8_BAR;
    PG8_BAR;
    if constexpr (Epi::AFTER_DRAIN) { E.fused(acc, cur, wr, wc, fr, fq, lds, wid, lane); S.done(cur); }
#undef PG8_SA
#undef PG8_SB
#undef PG8_STAGE
#undef PG8_LDA
#undef PG8_LDB
#undef PG8_MMA
#undef PG8_WAIT_V
#undef PG8_WAIT_L
#undef PG8_BAR
#undef PG8_SCHED
}
}

using pg8::bf16_t; using pg8::bf16x8; using pg8::f32x4; using pg8::u32x4; using pg8::Unit; using pg8::cvt_pk_bf16;
#define LAS __attribute__((address_space(3)))
typedef float f32x16 __attribute__((ext_vector_type(16)));
typedef float f32x2v __attribute__((ext_vector_type(2)));
typedef unsigned u32x2 __attribute__((ext_vector_type(2)));

constexpr int NTOK_P = 8192, NTOK = 9216;
constexpr size_t PLANE = (size_t)NTOK * 2048;
constexpr float EPS = 1e-6f;

constexpr size_t WS_X16 = 0;
constexpr size_t WS_WINT = 37748736;
constexpr size_t WS_MIX = 0;
constexpr size_t WS_WGLU = 79691776;
constexpr size_t WS_WOUT = 88080384;
constexpr size_t WS_Z = 104857600;
constexpr size_t WS_RSCALE = 293601280;
constexpr size_t WS_SSQ = WS_RSCALE + 36864;
constexpr size_t WS_TAB = WS_SSQ;
constexpr size_t WS_CNT2 = WS_SSQ + 16384;
constexpr size_t WS_CNT = WS_SSQ + 4096;
constexpr size_t WS_PART = WS_Z;
constexpr size_t WS_LAM = WS_SSQ + 36864;
constexpr size_t WS_BT = WS_LAM + 65536;
constexpr size_t WS_CT = WS_BT + 524288;
constexpr size_t WS_WS16 = WS_CT + 524288;
constexpr size_t WS_YB = WS_WS16 + 262144;
constexpr size_t WS_EXCH = WS_YB + 37748736;
constexpr size_t WS_BAR = WS_EXCH + 294912;
constexpr size_t WS_END = WS_BAR + 16384;
constexpr int REP0 = 1, REP2 = 1, REP3 = 1;

constexpr size_t O_RE_P = 18874368, O_IM_P = 18907136, O_RE_S = 18939904, O_IM_S = 19988480, O_V = 21037056;

constexpr int S5_ROWB = 528;
constexpr int S5_WAVE_B = 32 * S5_ROWB;
constexpr int LDS_MAIN = 8 * S5_WAVE_B;
constexpr int LDS_BYTES = LDS_MAIN + 16;

struct Params {
    const float *xp, *xs, *sre, *sim, *g_norm, *w_in, *g_v, *w_s, *b_s, *a_re, *a_im, *log_dt, *b_re, *b_im, *c_re, *c_im, *d_skip, *w_glu, *b_glu, *w_out, *g_final;
    float* out; unsigned char* ws;
};

__device__ __forceinline__ float bflo(unsigned w) { return __uint_as_float(w << 16); }
__device__ __forceinline__ float bfhi(unsigned w) { return __uint_as_float(w & 0xffff0000u); }
__device__ __forceinline__ float sigmoid_fast(float t) { return __builtin_amdgcn_rcpf(1.0f + __builtin_amdgcn_exp2f(-1.44269504f * t)); }
__device__ __forceinline__ float gelu_tanh(float x) { return x * sigmoid_fast(x * (1.5957691216f + 0.0713548163f * x * x)); }
__device__ __forceinline__ float silu_f(float x) { return x * sigmoid_fast(x); }
__device__ __forceinline__ f32x2v act_pk(f32x2v x, float c1n, float c3n) {
    const f32x2v q = x * x;
    const f32x2v t = x * (q * c3n + c1n);
    f32x2v e; e.x = __builtin_amdgcn_exp2f(t.x); e.y = __builtin_amdgcn_exp2f(t.y);
    const f32x2v d = e + 1.0f;
    f32x2v r; r.x = __builtin_amdgcn_rcpf(d.x); r.y = __builtin_amdgcn_rcpf(d.y);
    return x * r;
}
__device__ __forceinline__ float wave_sum(float v) {
#pragma unroll
    for (int o = 32; o >= 1; o >>= 1) v += __shfl_xor(v, o);
    return v;
}
#define LGKM0() asm volatile("s_waitcnt lgkmcnt(0)" ::: "memory")
#define WAVE_ORDER() asm volatile("" ::: "memory")


#define XB_TMO      128
#define XB_XCNT(j)  (256  + 64 * (j))
#define XB_XSUB(j)  (1280 + 64 * (j))
#define XB_XGEN(j)  (2304 + 64 * (j))
#define XB_TOP      3328
#define XB_TOPGEN   3392
#define XCD_BAR_WORDS 3456
#define XB_SPIN_CAP (1u << 18)
__device__ __forceinline__ unsigned xb_ld(unsigned* p)              { return __hip_atomic_load(p, __ATOMIC_RELAXED, __HIP_MEMORY_SCOPE_AGENT); }
__device__ __forceinline__ unsigned xb_add(unsigned* p, unsigned v) { return __hip_atomic_fetch_add(p, v, __ATOMIC_RELAXED, __HIP_MEMORY_SCOPE_AGENT); }
__device__ __forceinline__ unsigned xb_xcc_id() { return (unsigned)__builtin_amdgcn_s_getreg((3 << 11) | 20) & 0xFu; }
#define XB_SPIN(cond, bar) do { unsigned _sp = 0; while (cond) { __builtin_amdgcn_s_sleep(1); \
    if ((++_sp & 255u) == 0u) { if (xb_ld(&(bar)[XB_TMO])) break; if (_sp > XB_SPIN_CAP) { atomicAdd(&(bar)[XB_TMO], 1u); break; } } } } while (0)

struct XcdBarrier {
    unsigned* bar; unsigned x;
    volatile LAS unsigned* st;
};

__device__ __forceinline__ XcdBarrier xcd_barrier_post(unsigned* bar, volatile LAS unsigned* st) {
    XcdBarrier b; b.bar = bar; b.x = xb_xcc_id(); b.st = st;
    if (threadIdx.x == 0) (void)xb_add(&bar[XB_XCNT(b.x)], 1u);
    return b;
}
__device__ __forceinline__ void xcd_barrier_complete(unsigned* bar, unsigned x, unsigned& nloc, unsigned& nx) {
    const unsigned G = gridDim.x * gridDim.y * gridDim.z;
    unsigned sum, cnt, mine, sp = 0u;
    for (;;) {
        sum = 0u; cnt = 0u; mine = 0u;
#pragma unroll
        for (unsigned j = 0; j < 16; ++j) { const unsigned c = xb_ld(&bar[XB_XCNT(j)]); sum += c; cnt += (c > 0u) ? 1u : 0u; mine = (j == x) ? c : mine; }
        if (sum == G) break;
        __builtin_amdgcn_s_sleep(1);
        if ((++sp & 255u) == 0u) { if (xb_ld(&bar[XB_TMO])) break; if (sp > XB_SPIN_CAP) { atomicAdd(&bar[XB_TMO], 1u); break; } }
    }
    nloc = mine > 0u ? mine : 1u; nx = cnt > 0u ? cnt : 1u;
}

__device__ __forceinline__ void xcd_barrier(const XcdBarrier& b) {
    asm volatile("s_waitcnt vmcnt(0)" ::: "memory");
    __syncthreads();
    if (threadIdx.x == 0) {
        unsigned* bar = b.bar;
        __builtin_amdgcn_s_waitcnt(0);
        unsigned nloc = b.st[0], nx = b.st[1];
        if (nloc == 0u) { xcd_barrier_complete(bar, b.x, nloc, nx); b.st[0] = nloc; b.st[1] = nx; }
        const unsigned old = xb_add(&bar[XB_XSUB(b.x)], 1u);
        const unsigned gen = old / nloc;
        if (old + 1u == (gen + 1u) * nloc) {
            __builtin_amdgcn_fence(__ATOMIC_RELEASE, "agent");
            asm volatile("s_waitcnt vmcnt(0)" ::: "memory");
            const unsigned og = xb_add(&bar[XB_TOP], 1u);
            const unsigned tg = og / nx;
            if (og + 1u == (tg + 1u) * nx) xb_add(&bar[XB_TOPGEN], 1u);
            else XB_SPIN(xb_ld(&bar[XB_TOPGEN]) == tg, bar);
            __builtin_amdgcn_fence(__ATOMIC_ACQUIRE, "agent");
            xb_add(&bar[XB_XGEN(b.x)], 1u);
            asm volatile("s_waitcnt vmcnt(0)" ::: "memory");
        } else {
            XB_SPIN(xb_ld(&bar[XB_XGEN(b.x)]) == gen, bar);
            __builtin_amdgcn_fence(__ATOMIC_ACQUIRE, "agent");
            asm volatile("s_waitcnt vmcnt(0)" ::: "memory");
        }
    }
    __syncthreads();
}

__device__ __forceinline__ float rsvc(const float (&a)[8], int i) { return a[i]; }
struct EpiInProj {
    static constexpr bool PERM = true, AFTER_DRAIN = false;
    bf16_t* Z; const float* rscale;
    __device__ __forceinline__ void operator()(const f32x4 (&acc)[2][2][4][2], const Unit& u, int wr, int wc, int fr, int fq) const {
        const int row0c = u.pm * 256 + wr * 64 + fr;
        if (u.pn < 16) {
            const int colc = u.pn * 128 + wc * 32 + 8 * fq;
#pragma unroll
            for (int ai = 0; ai < 2; ++ai)
#pragma unroll
                for (int m = 0; m < 4; ++m) {
                    f32x2v pr[4];
#pragma unroll
                    for (int n = 0; n < 2; ++n) { const f32x4 ua = acc[ai][0][m][n], ga = acc[ai][1][m][n];
                        pr[2 * n] = act_pk((f32x2v){ua[0], ua[1]}, -1.44269504f * 1.5957691216f, -1.44269504f * 0.0713548163f) * act_pk((f32x2v){ga[0], ga[1]}, -1.44269504f, 0.0f);
                        pr[2 * n + 1] = act_pk((f32x2v){ua[2], ua[3]}, -1.44269504f * 1.5957691216f, -1.44269504f * 0.0713548163f) * act_pk((f32x2v){ga[2], ga[3]}, -1.44269504f, 0.0f); }
                    u32x4 w; w.x = cvt_pk_bf16(pr[0].x, pr[0].y); w.y = cvt_pk_bf16(pr[1].x, pr[1].y); w.z = cvt_pk_bf16(pr[2].x, pr[2].y); w.w = cvt_pk_bf16(pr[3].x, pr[3].y);
                    *(u32x4*)(Z + (size_t)(row0c + ai * 128 + m * 16) * 2048 + colc) = w;
                }
            return;
        }
        const int sq = (u.pn >> 3) - 2;
        const int sec = (sq == 0) ? 1 : (sq == 1) ? 3 : 4;
        const float c1n = (sec < 2) ? -1.44269504f * 1.5957691216f : -1.44269504f, c3n = (sec < 2) ? -1.44269504f * 0.0713548163f : 0.0f;
        const bool ident = (sec == 3);
        bf16_t* base = Z + (size_t)sec * PLANE;
        const int row0 = u.pm * 256 + wr * 64 + fr, col0 = (u.pn & 7) * 256 + wc * 32 + 8 * fq;
#pragma unroll
        for (int ai = 0; ai < 2; ++ai)
#pragma unroll
            for (int m = 0; m < 4; ++m) {
                const int row = row0 + ai * 128 + m * 16;
                bf16_t* rowp = base + (size_t)row * 2048 + col0;
#pragma unroll
                for (int bj = 0; bj < 2; ++bj) {
                    f32x2v v2[4];
#pragma unroll
                    for (int n = 0; n < 2; ++n) { const f32x4 a4 = acc[ai][bj][m][n]; v2[2 * n] = (f32x2v){a4[0], a4[1]}; v2[2 * n + 1] = (f32x2v){a4[2], a4[3]}; }
                    if (!ident) {
#pragma unroll
                        for (int j = 0; j < 4; ++j) v2[j] = act_pk(v2[j], c1n, c3n);
                    }
                    u32x4 w; w.x = cvt_pk_bf16(v2[0].x, v2[0].y); w.y = cvt_pk_bf16(v2[1].x, v2[1].y); w.z = cvt_pk_bf16(v2[2].x, v2[2].y); w.w = cvt_pk_bf16(v2[3].x, v2[3].y);
                    *(u32x4*)(rowp + bj * 128) = w;
                }
            }
    }
};
struct EpiGlu {
    static constexpr bool PERM = true, AFTER_DRAIN = false;
    const bf16_t* YB; const bf16_t* SGB; const float* bias; bf16_t* MIX; float* part; int tu;
    __device__ __forceinline__ void operator()(const f32x4 (&acc)[2][2][4][2], const Unit& u, int wr, int wc, int fr, int fq) const {
        const int row0 = u.pm * 256 + wr * 64 + fr, col0 = u.pn * 256 + wc * 32 + 8 * fq;
        if (u.nkt != 32) {
            bf16_t* pt = (bf16_t*)part + ((size_t)(u.k0 / (u.nkt * 64)) * 32 + tu) * 65536 + (size_t)((wr * 4 + wc) * 16) * 512 + (fq * 16 + fr) * 8;
#pragma unroll
            for (int ai = 0; ai < 2; ++ai)
#pragma unroll
                for (int m = 0; m < 4; ++m)
#pragma unroll
                    for (int bj = 0; bj < 2; ++bj) {
                        const f32x4 v0 = acc[ai][bj][m][0], v1 = acc[ai][bj][m][1];
                        u32x4 w; w.x = cvt_pk_bf16(v0[0], v0[1]); w.y = cvt_pk_bf16(v0[2], v0[3]); w.z = cvt_pk_bf16(v1[0], v1[1]); w.w = cvt_pk_bf16(v1[2], v1[3]);
                        bf16_t* dst = pt + ((ai * 4 + m) * 2 + bj) * 512;
                        asm volatile("global_store_dwordx4 %0, %1, off sc1\n\ts_nop 2" :: "v"(dst), "v"(w) : "memory");
                    }
            return;
        }
        f32x4 bv[2][2];
#pragma unroll
        for (int bj = 0; bj < 2; ++bj)
#pragma unroll
            for (int n = 0; n < 2; ++n) bv[bj][n] = *(const f32x4*)(bias + col0 + bj * 128 + 4 * n);
#pragma unroll
        for (int ai = 0; ai < 4; ++ai) {
            u32x4 ybv[2][2], gbv[2][2];
#pragma unroll
            for (int m = 0; m < 2; ++m)
#pragma unroll
                for (int bj = 0; bj < 2; ++bj) { const size_t row = (size_t)(row0 + (ai >> 1) * 128 + ((ai & 1) * 2 + m) * 16);
                    ybv[m][bj] = *(const u32x4*)(YB + row * 2048 + col0 + bj * 128); gbv[m][bj] = *(const u32x4*)(SGB + row * 2048 + col0 + bj * 128); }
#pragma unroll
            for (int m = 0; m < 2; ++m) {
                const size_t row = (size_t)(row0 + (ai >> 1) * 128 + ((ai & 1) * 2 + m) * 16);
#pragma unroll
                for (int bj = 0; bj < 2; ++bj) {
                    const u32x4 yb = ybv[m][bj], gb = gbv[m][bj];
                    f32x2v o2[4];
#pragma unroll
                    for (int w = 0; w < 4; ++w) {
                        const f32x4 a4 = acc[ai >> 1][bj][(ai & 1) * 2 + m][w >> 1], b4 = bv[bj][w >> 1];
                        const f32x2v t = ((f32x2v){a4[(w & 1) * 2], a4[(w & 1) * 2 + 1]} + (f32x2v){b4[(w & 1) * 2], b4[(w & 1) * 2 + 1]}) * -1.44269504f;
                        f32x2v e; e.x = __builtin_amdgcn_exp2f(t.x); e.y = __builtin_amdgcn_exp2f(t.y);
                        const f32x2v d = e + 1.0f;
                        f32x2v r; r.x = __builtin_amdgcn_rcpf(d.x); r.y = __builtin_amdgcn_rcpf(d.y);
                        o2[w] = ((f32x2v){bflo(yb[w]), bfhi(yb[w])} * (f32x2v){bflo(gb[w]), bfhi(gb[w])}) * r;
                    }
                    u32x4 wv; wv.x = cvt_pk_bf16(o2[0].x, o2[0].y); wv.y = cvt_pk_bf16(o2[1].x, o2[1].y); wv.z = cvt_pk_bf16(o2[2].x, o2[2].y); wv.w = cvt_pk_bf16(o2[3].x, o2[3].y);
                    *(u32x4*)(MIX + row * 4096 + 2048 + col0 + bj * 128) = wv;
                }
            }
        }
    }
};
struct EpiOut {
    static constexpr bool PERM = false, AFTER_DRAIN = false;
    const float* xp; const float* xs; float* out; float* part; int tu;
    __device__ __forceinline__ void operator()(const f32x4 (&acc)[2][2][4][2], const Unit& u, int wr, int wc, int fr, int fq) const {
        const int row0 = u.pm * 256 + wr * 64 + fr, col0 = u.pn * 256 + wc * 32 + 4 * fq;
        const float* xb = (u.pm < 32) ? xp : xs - (size_t)NTOK_P * 2048;
        const bool split = (u.nkt != 64);
        if (!split) {
#pragma unroll
            for (int a4 = 0; a4 < 4; ++a4) {
                const int ai = a4 >> 1, m0 = (a4 & 1) * 2;
                f32x4 xv[2][2][2];
#pragma unroll
                for (int m = 0; m < 2; ++m)
#pragma unroll
                    for (int bj = 0; bj < 2; ++bj)
#pragma unroll
                        for (int n = 0; n < 2; ++n) xv[m][bj][n] = *(const f32x4*)(xb + (size_t)(row0 + ai * 128 + (m0 + m) * 16) * 2048 + col0 + bj * 128 + n * 16);
#pragma unroll
                for (int m = 0; m < 2; ++m)
#pragma unroll
                    for (int bj = 0; bj < 2; ++bj)
#pragma unroll
                        for (int n = 0; n < 2; ++n) *(f32x4*)(out + (size_t)(row0 + ai * 128 + (m0 + m) * 16) * 2048 + col0 + bj * 128 + n * 16) = xv[m][bj][n] + acc[ai][bj][m0 + m][n];
            }
        } else {
            float* pt = part + ((size_t)(u.k0 / (u.nkt * 64)) * 32 + tu) * 65536 + (size_t)(wr * 64 + fr) * 256 + wc * 32 + 4 * fq;
#pragma unroll
            for (int ai = 0; ai < 2; ++ai)
#pragma unroll
                for (int m = 0; m < 4; ++m)
#pragma unroll
                    for (int bj = 0; bj < 2; ++bj)
#pragma unroll
                        for (int n = 0; n < 2; ++n) *(f32x4*)(pt + (size_t)(ai * 128 + m * 16) * 256 + bj * 128 + n * 16) = acc[ai][bj][m][n];
        }
    }
};

struct OutOrder {
    int c;
    __device__ __forceinline__ bool next(int i, Unit& u) const {
        const int j = c >> 3, x = c & 7; const bool first = (i == 0);
        u.pm = first ? 32 + (j >> 3) : 4 * x + (j >> 3); u.pn = j & 7; u.k0 = first ? x * 512 : 0; u.nkt = first ? 8 : 64;
        return i < 2;
    }
    __device__ __forceinline__ void a_ready(const Unit&) const {}
    __device__ __forceinline__ void done(const Unit&) const {}
};
struct EpiOutF {
    static constexpr bool PERM = false, AFTER_DRAIN = true;
    const float* xp; float* out; const float* gfin; unsigned char* ws;
    __device__ __forceinline__ void operator()(const f32x4 (&acc)[2][2][4][2], const Unit& u, int wr, int wc, int fr, int fq) const {
        const int tu = (u.pm - 32) * 8 + u.pn;
        bf16_t* pt = (bf16_t*)(ws + WS_PART) + ((size_t)(u.k0 / 512) * 32 + tu) * 65536 + (size_t)(wr * 64 + fr) * 256 + wc * 32 + 4 * fq;
#pragma unroll
        for (int ai = 0; ai < 2; ++ai)
#pragma unroll
            for (int m = 0; m < 4; ++m)
#pragma unroll
                for (int bj = 0; bj < 2; ++bj)
#pragma unroll
                    for (int n = 0; n < 2; ++n) { const f32x4 v = acc[ai][bj][m][n]; u32x2 w; w.x = cvt_pk_bf16(v[0], v[1]); w.y = cvt_pk_bf16(v[2], v[3]);
                        *(u32x2*)(pt + (size_t)(ai * 128 + m * 16) * 256 + bj * 128 + n * 16) = w; }
    }
    __device__ __forceinline__ void fused(f32x4 (&acc)[2][2][4][2], const Unit& u, int wr, int wc, int fr, int fq, PG8_LAS unsigned char* lds, int wid, int lane) const {
        PG8_LAS float* P = (PG8_LAS float*)lds;
        float* exch = (float*)(ws + WS_EXCH); unsigned* cnt = (unsigned*)(ws + WS_CNT2);
        PG8_LAS float* Sx = (PG8_LAS float*)(lds + 4096);
        const int row0 = u.pm * 256 + wr * 64 + fr, col0 = u.pn * 256 + wc * 32 + 4 * fq;
#pragma unroll
        for (int a8 = 0; a8 < 8; ++a8) {
            const int ai = a8 >> 2, m = a8 & 3;
            f32x4 xv[2][2];
#pragma unroll
            for (int bj = 0; bj < 2; ++bj)
#pragma unroll
                for (int n = 0; n < 2; ++n) xv[bj][n] = *(const f32x4*)(xp + (size_t)(row0 + ai * 128 + m * 16) * 2048 + col0 + bj * 128 + n * 16);
            float sq = 0.f;
#pragma unroll
            for (int bj = 0; bj < 2; ++bj)
#pragma unroll
                for (int n = 0; n < 2; ++n) { const f32x4 o = xv[bj][n] + acc[ai][bj][m][n]; acc[ai][bj][m][n] = o; sq += (o[0] * o[0] + o[1] * o[1]) + (o[2] * o[2] + o[3] * o[3]); }
            sq += __shfl_xor(sq, 16); sq += __shfl_xor(sq, 32);
            if (fq == 0) P[(ai * 128 + wr * 64 + m * 16 + fr) * 4 + wc] = sq;
        }
        asm volatile("s_waitcnt lgkmcnt(0)" ::: "memory"); __builtin_amdgcn_s_barrier(); asm volatile("" ::: "memory");
        const int tid = wid * 64 + lane;
        if (tid < 256) {
            const float t = (P[tid * 4 + 0] + P[tid * 4 + 1]) + (P[tid * 4 + 2] + P[tid * 4 + 3]);
            __hip_atomic_store(exch + ((size_t)(u.pm * 256 + tid) * 8 + u.pn), t, __ATOMIC_RELAXED, __HIP_MEMORY_SCOPE_AGENT);
            asm volatile("s_waitcnt vmcnt(0)" ::: "memory");
            if (lane == 0) __hip_atomic_fetch_add(cnt + 64 * u.pm, 1u, __ATOMIC_RELAXED, __HIP_MEMORY_SCOPE_AGENT);
        }
        if (wid == 0) {
            unsigned sp = 0;
            while ((unsigned)__builtin_amdgcn_readfirstlane(__hip_atomic_load(cnt + 64 * u.pm, __ATOMIC_RELAXED, __HIP_MEMORY_SCOPE_AGENT)) < 32u) { __builtin_amdgcn_s_sleep(2); if (++sp > (1u << 22)) break; }
            __builtin_amdgcn_fence(__ATOMIC_ACQUIRE, "agent");
        }
        asm volatile("s_waitcnt vmcnt(0) lgkmcnt(0)" ::: "memory"); __builtin_amdgcn_s_barrier(); asm volatile("" ::: "memory");
        if (tid < 256) {
            const float* sl = exch + (size_t)(u.pm * 256 + tid) * 8; float t = 0.f;
#pragma unroll
            for (int q = 0; q < 8; ++q) t += __hip_atomic_load(sl + q, __ATOMIC_RELAXED, __HIP_MEMORY_SCOPE_AGENT);
            Sx[tid] = rsqrtf(t * (1.0f / 2048.0f) + EPS);
        }
        asm volatile("s_waitcnt lgkmcnt(0)" ::: "memory"); __builtin_amdgcn_s_barrier(); asm volatile("" ::: "memory");
        f32x4 gv[2][2];
#pragma unroll
        for (int bj = 0; bj < 2; ++bj)
#pragma unroll
            for (int n = 0; n < 2; ++n) gv[bj][n] = *(const f32x4*)(gfin + col0 + bj * 128 + n * 16);
#pragma unroll
        for (int ai = 0; ai < 2; ++ai)
#pragma unroll
            for (int m = 0; m < 4; ++m) {
                const int rl = ai * 128 + wr * 64 + m * 16 + fr; const float rs = Sx[rl];
#pragma unroll
                for (int bj = 0; bj < 2; ++bj)
#pragma unroll
                    for (int n = 0; n < 2; ++n) __builtin_nontemporal_store(acc[ai][bj][m][n] * rs * gv[bj][n], (f32x4*)(out + (size_t)(u.pm * 256 + rl) * 2048 + col0 + bj * 128 + n * 16));
            }
    }
};

__device__ __forceinline__ void glu_tail_reduce(const Params& p, const pg8::StaticOrder& S, int G) {
    const int tid = threadIdx.x, bid = blockIdx.x, tu = bid / S.nsplit, kc = bid % S.nsplit;
    unsigned* cnt = (unsigned*)(p.ws + WS_CNT) + tu * 64;
    if (tid == 0) {
        unsigned sp = 0;
        while (__hip_atomic_load(cnt, __ATOMIC_RELAXED, __HIP_MEMORY_SCOPE_AGENT) < (unsigned)S.nsplit * 8u) { __builtin_amdgcn_s_sleep(2); if (++sp > (1u << 22)) break; }
        __builtin_amdgcn_fence(__ATOMIC_ACQUIRE, "agent");
        asm volatile("s_waitcnt vmcnt(0)" ::: "memory");
    }
    __syncthreads();
    Unit u; S.map((S.nwg / G) * G + tu, u);
    const bf16_t* part = (const bf16_t*)(p.ws + WS_PART) + (size_t)tu * 65536;
    const bf16_t* YB = (const bf16_t*)(p.ws + WS_YB); const bf16_t* SGB = (const bf16_t*)(p.ws + WS_Z) + 4 * PLANE; bf16_t* MIX = (bf16_t*)(p.ws + WS_MIX);
    const int rl = kc * 32 + (tid >> 4), cl = (tid & 15) * 16;
    const size_t row = (size_t)(u.pm * 256 + rl); const int col = u.pn * 256 + cl;
    f32x4 a[4];
#pragma unroll
    for (int q = 0; q < 4; ++q) a[q] = *(const f32x4*)(p.b_glu + col + 4 * q);
    const int r_ai = rl >> 7, r_wr = (rl >> 6) & 1, r_m = (rl >> 4) & 3, r_fr = rl & 15, r_bj = cl >> 7, r_wc = (cl >> 5) & 3, r_fq0 = (cl >> 3) & 3;
    const size_t lidx = (size_t)((((r_wr * 4 + r_wc) * 2 + r_ai) * 4 + r_m) * 2 + r_bj) * 512 + (r_fq0 * 16 + r_fr) * 8;
#pragma unroll
    for (int c8 = 0; c8 < 8; ++c8)
#pragma unroll
        for (int q = 0; q < 2; ++q) { const u32x4 w = *(const u32x4*)(part + (size_t)c8 * 32 * 65536 + lidx + q * 128);
            a[2 * q] += (f32x4){bflo(w.x), bfhi(w.x), bflo(w.y), bfhi(w.y)}; a[2 * q + 1] += (f32x4){bflo(w.z), bfhi(w.z), bflo(w.w), bfhi(w.w)}; }
    u32x4 yb[2], gb[2], o[2];
#pragma unroll
    for (int q = 0; q < 2; ++q) { yb[q] = *(const u32x4*)(YB + row * 2048 + col + 8 * q); gb[q] = *(const u32x4*)(SGB + row * 2048 + col + 8 * q); }
#pragma unroll
    for (int q = 0; q < 2; ++q)
#pragma unroll
        for (int w = 0; w < 4; ++w) {
            const f32x4 av = a[2 * q + (w >> 1)];
            const float lo = bflo(yb[q][w]) * sigmoid_fast(av[(w & 1) * 2]) * bflo(gb[q][w]), hi = bfhi(yb[q][w]) * sigmoid_fast(av[(w & 1) * 2 + 1]) * bfhi(gb[q][w]);
            o[q][w] = cvt_pk_bf16(lo, hi);
        }
#pragma unroll
    for (int q = 0; q < 2; ++q) *(u32x4*)(MIX + row * 4096 + 2048 + col + 8 * q) = o[q];
}

__device__ __forceinline__ void sincos_d(double x, double& s, double& c) {
    const double q = rint(x * 0.6366197723675814);
    double r = fma(-q, 1.5707963267948966, x); r = fma(-q, 6.123233995736766e-17, r);
    const int qi = (int)q; const double r2 = r * r;
    const double sp = r * (1.0 + r2 * (-1.0 / 6 + r2 * (1.0 / 120 + r2 * (-1.0 / 5040 + r2 * (1.0 / 362880 + r2 * (-1.0 / 39916800 + r2 * (1.0 / 6227020800.0)))))));
    const double cp = 1.0 + r2 * (-0.5 + r2 * (1.0 / 24 + r2 * (-1.0 / 720 + r2 * (1.0 / 40320 + r2 * (-1.0 / 3628800 + r2 * (1.0 / 479001600 + r2 * (-1.0 / 87178291200.0)))))));
    const int k = qi & 3;
    s = (k == 0) ? sp : (k == 1) ? cp : (k == 2) ? -sp : -cp;
    c = (k == 0) ? cp : (k == 1) ? -sp : (k == 2) ? -cp : sp;
}
__device__ __forceinline__ double exp_d(double x) {
    const double k = rint(x * 1.4426950408889634);
    double r = fma(-k, 0.6931471805599453, x); r = fma(-k, 2.3190468138462996e-17, r);
    double p = 1.0 / 479001600;
    p = p * r + 1.0 / 39916800; p = p * r + 1.0 / 3628800; p = p * r + 1.0 / 362880; p = p * r + 1.0 / 40320; p = p * r + 1.0 / 5040; p = p * r + 1.0 / 720;
    p = p * r + 1.0 / 120; p = p * r + 1.0 / 24; p = p * r + 1.0 / 6; p = p * r + 0.5; p = p * r + 1.0; p = p * r + 1.0;
    return __builtin_ldexp(p, (int)k);
}

__device__ __forceinline__ void transpose_tiles(const Params& p, LAS unsigned char* lds, int t0, int t1, int start, int stride) {
    const int tid = threadIdx.x; unsigned char* ws = p.ws;
    LAS float* tile = (LAS float*)lds;
    constexpr int TS = 260;
    f32x4 r[8]; float sc[8];
    auto tile_of = [&](int t, const float*& src, bf16_t*& dst, int& K, int& N, int& kt, int& nt, const float*& gk) {
        int tl; gk = nullptr;
        if (t < 1280) { src = p.w_in; dst = (bf16_t*)(ws + WS_WINT); K = 2048; N = 10240; tl = t; gk = p.g_norm; }
        else if (t < 1536) { src = p.w_glu; dst = (bf16_t*)(ws + WS_WGLU); K = 2048; N = 2048; tl = t - 1280; }
        else { src = p.w_out; dst = (bf16_t*)(ws + WS_WOUT); K = 4096; N = 2048; tl = t - 1536; }
        const int tn = N / 256; kt = tl / tn; nt = tl % tn; };
    auto load_tile = [&](int t) {
        const float* src; bf16_t* dst; int K, N, kt, nt; const float* gk; tile_of(t, src, dst, K, N, kt, nt, gk);
#pragma unroll
        for (int i = 0; i < 8; ++i) { const int k = (tid >> 6) + 8 * i;
            r[i] = __builtin_nontemporal_load((const f32x4*)(src + (size_t)(kt * 64 + k) * N + nt * 256 + (tid & 63) * 4)); sc[i] = gk ? gk[kt * 64 + k] : 1.0f; } };
    int t = t0 + start;
    if (t < t1) load_tile(t);
    for (; t < t1; t += stride) {
        const float* src; bf16_t* dst; int K, N, kt, nt; const float* gk; tile_of(t, src, dst, K, N, kt, nt, gk);
#pragma unroll
        for (int i = 0; i < 8; ++i) { const int k = (tid >> 6) + 8 * i; *(LAS f32x4*)(tile + k * TS + (tid & 63) * 4) = r[i] * sc[i]; }
        __syncthreads();
        if (t + stride < t1) load_tile(t + stride);
        {
            const int n = tid >> 1, kh = (tid & 1) * 32; float v[32];
#pragma unroll
            for (int j = 0; j < 32; ++j) v[j] = tile[(kh + j) * TS + n];
            int nrow = nt * 256 + n;
            if (t < 1280) {
                if (nrow < 2048) nrow = (nrow >> 7) * 256 + (nrow & 127);
                else if (nrow < 4096) nrow += 2048;
                else if (nrow < 6144) { const int c = nrow - 4096; nrow = (c >> 7) * 256 + 128 + (c & 127); }
            }
            bf16_t* dp = dst + (size_t)nrow * K + kt * 64 + kh;
#pragma unroll
            for (int q = 0; q < 4; ++q) { u32x4 w; w.x = cvt_pk_bf16(v[8 * q], v[8 * q + 1]); w.y = cvt_pk_bf16(v[8 * q + 2], v[8 * q + 3]); w.z = cvt_pk_bf16(v[8 * q + 4], v[8 * q + 5]); w.w = cvt_pk_bf16(v[8 * q + 6], v[8 * q + 7]);
                *(u32x4*)(dp + 8 * q) = w; }
        }
        __syncthreads();
    }
}
__device__ __forceinline__ void build_tables(const Params& p, int gt, int GS, int G) {
    unsigned char* ws = p.ws;
    float* lam = (float*)(ws + WS_LAM); bf16_t* Bt = (bf16_t*)(ws + WS_BT); bf16_t* Ct = (bf16_t*)(ws + WS_CT); bf16_t* W16 = (bf16_t*)(ws + WS_WS16);
    for (int idx = gt; idx < 131072; idx += GS) {
        const int c = idx & 15, gp = idx >> 4, g = gp >> 6, pp = gp & 63;
        const double dt = exp_d((double)p.log_dt[g]), are = (double)p.a_re[gp], aim = (double)p.a_im[gp];
        const double mag = exp_d(are * dt); double sn, cs; sincos_d(aim * dt, sn, cs);
        const double lr = mag * cs, li = mag * sn;
        if (c == 0) { lam[gp * 2] = (float)lr; lam[gp * 2 + 1] = (float)li; }
        const double den = are * are + aim * aim, nr = lr - 1.0, ni = li;
        const double fr_ = (nr * are + ni * aim) / den, fi_ = (ni * are - nr * aim) / den;
        const double br = (double)p.b_re[idx], bi = (double)p.b_im[idx];
        const unsigned w = cvt_pk_bf16((float)(fr_ * br - fi_ * bi), (float)(fr_ * bi + fi_ * br));
        Bt[((size_t)g * 128 + 2 * pp) * 16 + c] = (bf16_t)(w & 0xffffu); Bt[((size_t)g * 128 + 2 * pp + 1) * 16 + c] = (bf16_t)(w >> 16);
    }
    for (int idx = gt; idx < 131072; idx += GS) {
        const int pp = idx & 63, gc = idx >> 6;
        *(unsigned*)(Ct + (size_t)gc * 128 + 2 * pp) = cvt_pk_bf16(p.c_re[idx], -p.c_im[idx]);
        const int s_ = idx & 127, tt = (idx >> 7) & 127;
        W16[idx] = (bf16_t)(cvt_pk_bf16(s_ <= tt ? p.w_s[idx] : 0.0f, 0.0f) & 0xffffu);
    }
    if (gt < 288) { pg8::StaticOrder S; S.init(NTOK, 2048, 4096, G, 0, 8); int v = -1;
        if (S.split_active()) { const int base = (S.nwg / G) * G; for (int t = 0; t < S.nwg - base; ++t) { Unit u; S.map(base + t, u); if (u.pm * 8 + u.pn == gt) v = t; } }
        ((int*)(ws + WS_TAB))[gt] = v; }
}
__device__ __forceinline__ int inproj_rem(int G) { return 1440 % G; }

__device__ __forceinline__ void phase0(const Params& p, LAS unsigned char* lds) {
    const int tid = threadIdx.x, G = gridDim.x, bid = blockIdx.x, wid = tid >> 6, lane = tid & 63;
    unsigned char* ws = p.ws;
    if (bid == 0) { for (int i = tid; i < 32 * 64; i += 512) ((unsigned*)(ws + WS_CNT))[i] = 0u; for (int i = tid; i < 36 * 64; i += 512) ((unsigned*)(ws + WS_CNT2))[i] = 0u; }
    transpose_tiles(p, lds, 0, 1280, bid, G);
    {
        bf16_t* X16 = (bf16_t*)(ws + WS_X16); float* rscale = (float*)(ws + WS_RSCALE);
        for (int row = bid * 8 + wid; row < NTOK; row += G * 8) {
            const float* xr = (row < NTOK_P) ? p.xp + (size_t)row * 2048 : p.xs + (size_t)(row - NTOK_P) * 2048;
            f32x4 v[8]; float ss = 0.f;
#pragma unroll
            for (int i = 0; i < 8; ++i) { v[i] = __builtin_nontemporal_load((const f32x4*)(xr + i * 256 + lane * 4)); ss += (v[i][0] * v[i][0] + v[i][1] * v[i][1]) + (v[i][2] * v[i][2] + v[i][3] * v[i][3]); }
            ss = wave_sum(ss);
            const float rs = rsqrtf(ss * (1.0f / 2048.0f) + EPS);
#pragma unroll
            for (int i = 0; i < 8; ++i) { u32x2 w; w.x = cvt_pk_bf16(v[i][0] * rs, v[i][1] * rs); w.y = cvt_pk_bf16(v[i][2] * rs, v[i][3] * rs); *(u32x2*)(X16 + (size_t)row * 2048 + i * 256 + lane * 4) = w; }
            if (lane == 0) rscale[row] = rs;
        }
    }
    if (inproj_rem(G) == 0) { transpose_tiles(p, lds, 1280, 2048, bid, G); build_tables(p, bid * 512 + tid, G * 512, G); }
}

__device__ __forceinline__ void spatial_units(const Params& p, LAS unsigned char* lds, int first, int stride) {
    const int tid = threadIdx.x, wid = __builtin_amdgcn_readfirstlane(tid >> 6), lane = tid & 63, fr = lane & 15, fq = lane >> 4;
    const bf16_t* Z = (const bf16_t*)(p.ws + WS_Z); const bf16_t* U = Z; const bf16_t* V = Z + PLANE; const bf16_t* GA = Z + 2 * PLANE;
    bf16_t* MIX = (bf16_t*)(p.ws + WS_MIX);
    constexpr int VS = 272, WOFF = 256 * VS;
    const int wr = wid >> 2, wc = wid & 3;
    const int pair = tid >> 3, oct = tid & 7, s0 = pair * 2;
    u32x4 r0[4], r1[4];
    int hcur = -1;
    if (first < 512) { const int h = first & 7, row0 = (first >> 3) * 128;
#pragma unroll
        for (int i = 0; i < 4; ++i) { const int pc = oct + 8 * i;
            r0[i] = __builtin_nontemporal_load((const u32x4*)(V + (size_t)(row0 + s0) * 2048 + h * 256 + pc * 8)); r1[i] = __builtin_nontemporal_load((const u32x4*)(V + (size_t)(row0 + s0 + 1) * 2048 + h * 256 + pc * 8)); } }
    for (int uid = first; uid < 512; uid += stride) {
        const int h = uid & 7, row0 = (uid >> 3) * 128;
        if (h != hcur) {
            const bf16_t* W = (const bf16_t*)(p.ws + WS_WS16) + (size_t)h * 16384;
#pragma unroll
            for (int i = 0; i < 4; ++i) { const int row = tid >> 2, piece = (tid & 3) + 4 * i; *(LAS u32x4*)(lds + WOFF + row * VS + piece * 16) = *(const u32x4*)(W + row * 128 + piece * 8); }
            hcur = h;
        }
        {
            float ss0 = 0.f, ss1 = 0.f;
#pragma unroll
            for (int i = 0; i < 4; ++i)
#pragma unroll
                for (int w = 0; w < 4; ++w) { const float a = bflo(r0[i][w]), b = bfhi(r0[i][w]), c = bflo(r1[i][w]), d = bfhi(r1[i][w]); ss0 += a * a + b * b; ss1 += c * c + d * d; }
            ss0 += __shfl_xor(ss0, 1); ss0 += __shfl_xor(ss0, 2); ss0 += __shfl_xor(ss0, 4);
            ss1 += __shfl_xor(ss1, 1); ss1 += __shfl_xor(ss1, 2); ss1 += __shfl_xor(ss1, 4);
            const float rs0 = rsqrtf(ss0 * (1.0f / 256.0f) + EPS), rs1 = rsqrtf(ss1 * (1.0f / 256.0f) + EPS);
#pragma unroll
            for (int i = 0; i < 4; ++i) { const int pc = oct + 8 * i;
                const f32x4 g0 = *(const f32x4*)(p.g_v + h * 256 + pc * 8), g1 = *(const f32x4*)(p.g_v + h * 256 + pc * 8 + 4);
#pragma unroll
                for (int w = 0; w < 4; ++w) {
                    const float ga = (w < 2) ? g0[2 * w] : g1[2 * w - 4], gb = (w < 2) ? g0[2 * w + 1] : g1[2 * w - 3];
                    const int d = pc * 8 + 2 * w;
                    *(LAS unsigned*)(lds + d * VS + s0 * 2) = cvt_pk_bf16(bflo(r0[i][w]) * rs0 * ga, bflo(r1[i][w]) * rs1 * ga);
                    *(LAS unsigned*)(lds + (d + 1) * VS + s0 * 2) = cvt_pk_bf16(bfhi(r0[i][w]) * rs0 * gb, bfhi(r1[i][w]) * rs1 * gb);
                }
            }
        }
        __syncthreads();
        if (uid + stride < 512) { const int un = uid + stride, hn = un & 7, rn = (un >> 3) * 128;
#pragma unroll
            for (int i = 0; i < 4; ++i) { const int pc = oct + 8 * i;
                r0[i] = __builtin_nontemporal_load((const u32x4*)(V + (size_t)(rn + s0) * 2048 + hn * 256 + pc * 8)); r1[i] = __builtin_nontemporal_load((const u32x4*)(V + (size_t)(rn + s0 + 1) * 2048 + hn * 256 + pc * 8)); } }
        float bsv[4];
#pragma unroll
        for (int mt = 0; mt < 4; ++mt) bsv[mt] = p.b_s[h * 128 + wr * 64 + mt * 16 + fr];
        u32x2 uua[4][4];
#pragma unroll
        for (int mt = 0; mt < 4; ++mt)
#pragma unroll
            for (int nt = 0; nt < 4; ++nt) uua[mt][nt] = *(const u32x2*)(U + (size_t)(row0 + wr * 64 + mt * 16 + fr) * 2048 + h * 256 + wc * 64 + nt * 16 + 4 * fq);
        f32x4 acc[4][4];
#pragma unroll
        for (int a = 0; a < 4; ++a)
#pragma unroll
            for (int b = 0; b < 4; ++b) acc[a][b] = (f32x4){0.f, 0.f, 0.f, 0.f};
#pragma unroll
        for (int kt = 0; kt < 4; ++kt) {
            if (32 * kt <= wr * 64 + 63) {
                bf16x8 wf[4], vf[4];
#pragma unroll
                for (int mt = 0; mt < 4; ++mt) wf[mt] = *(const LAS bf16x8*)(lds + WOFF + (wr * 64 + mt * 16 + fr) * VS + (32 * kt + 8 * fq) * 2);
#pragma unroll
                for (int nt = 0; nt < 4; ++nt) vf[nt] = *(const LAS bf16x8*)(lds + (wc * 64 + nt * 16 + fr) * VS + (32 * kt + 8 * fq) * 2);
#pragma unroll
                for (int mt = 0; mt < 4; ++mt)
#pragma unroll
                    for (int nt = 0; nt < 4; ++nt) acc[mt][nt] = __builtin_amdgcn_mfma_f32_16x16x32_bf16(vf[nt], wf[mt], acc[mt][nt], 0, 0, 0);
            }
        }
#pragma unroll
        for (int mt = 0; mt < 4; ++mt) {
            const int t = wr * 64 + mt * 16 + fr; const size_t row = (size_t)(row0 + t); const float bs = bsv[mt];
#pragma unroll
            for (int nt = 0; nt < 4; ++nt) {
                const int d0 = h * 256 + wc * 64 + nt * 16 + 4 * fq;
                const u32x2 u2 = uua[mt][nt];
                u32x2 o;
                o.x = cvt_pk_bf16(bflo(u2.x) * (acc[mt][nt][0] + bs), bfhi(u2.x) * (acc[mt][nt][1] + bs));
                o.y = cvt_pk_bf16(bflo(u2.y) * (acc[mt][nt][2] + bs), bfhi(u2.y) * (acc[mt][nt][3] + bs));
                *(u32x2*)(MIX + row * 4096 + d0) = o;
            }
        }
        __syncthreads();
    }
}

__device__ __forceinline__ void spatial_sample_task(const Params& p, int seq, int h, int lane) {
    const bf16_t* Z = (const bf16_t*)(p.ws + WS_Z); const bf16_t* U = Z; const bf16_t* V = Z + PLANE; const bf16_t* GA = Z + 2 * PLANE;
    bf16_t* MIX = (bf16_t*)(p.ws + WS_MIX);
    const int c0 = h * 256 + lane * 4;
    const f32x4 gv = *(const f32x4*)(p.g_v + c0);
    f32x4 vn[8];
#pragma unroll
    for (int j = 0; j < 8; ++j) {
        const size_t row = (size_t)(NTOK_P + seq * 8 + j);
        const u32x2 r = *(const u32x2*)(V + row * 2048 + c0);
        f32x4 x = (f32x4){bflo(r.x), bfhi(r.x), bflo(r.y), bfhi(r.y)};
        const float ss = wave_sum((x[0] * x[0] + x[1] * x[1]) + (x[2] * x[2] + x[3] * x[3]));
        const float rs = rsqrtf(ss * (1.0f / 256.0f) + EPS);
        vn[j] = x * rs * gv;
        __builtin_nontemporal_store(vn[j], (f32x4*)(p.out + O_V + (size_t)(seq * 8 + j) * 2048 + c0));
    }
#pragma unroll
    for (int t = 0; t < 8; ++t) {
        const float bs = p.b_s[h * 128 + t];
        f32x4 m = (f32x4){bs, bs, bs, bs};
#pragma unroll
        for (int s = 0; s <= t; ++s) m += p.w_s[(size_t)(h * 128 + t) * 128 + s] * vn[s];
        const size_t row = (size_t)(NTOK_P + seq * 8 + t);
        const u32x2 uu = *(const u32x2*)(U + row * 2048 + c0);
        u32x2 o;
        o.x = cvt_pk_bf16(bflo(uu.x) * m[0], bfhi(uu.x) * m[1]);
        o.y = cvt_pk_bf16(bflo(uu.y) * m[2], bfhi(uu.y) * m[3]);
        *(u32x2*)(MIX + row * 4096 + c0) = o;
    }
}

__device__ __forceinline__ void s5_task(const Params& p, LAS unsigned char* wl, int task, int lane) {
    const bool sample = task >= 512;
    const int g = task & 127;
    int row0, ntiles, seq0 = 0; float* ore; float* oim;
    if (!sample) { const int b = task >> 7; row0 = b * 2048; ntiles = 64; ore = p.out + O_RE_P + (size_t)(b * 128 + g) * 64; oim = p.out + O_IM_P + (size_t)(b * 128 + g) * 64; }
    else { const int tb = (task - 512) >> 7; row0 = NTOK_P + tb * 256; ntiles = 8; seq0 = tb * 32; ore = p.out + O_RE_S + (size_t)g * 64; oim = p.out + O_IM_S + (size_t)g * 64; }
    const int r = lane & 31, hh = lane >> 5, fr = lane & 15, fq = lane >> 4;
    const float* lam = (const float*)(p.ws + WS_LAM);
    const float lr = lam[(g * 64 + lane) * 2], li = lam[(g * 64 + lane) * 2 + 1];
    const bf16_t* Bt = (const bf16_t*)(p.ws + WS_BT); const bf16_t* Ct = (const bf16_t*)(p.ws + WS_CT);
    bf16x8 btf[4], ctf[4];
#pragma unroll
    for (int mt = 0; mt < 4; ++mt) btf[mt] = *(const bf16x8*)(Bt + ((size_t)(g * 128 + 32 * mt + r) * 16 + 8 * hh));
#pragma unroll
    for (int kt = 0; kt < 4; ++kt) ctf[kt] = *(const bf16x8*)(Ct + ((size_t)(g * 16 + fr) * 128 + 32 * kt + 8 * fq));
    const f32x4 dsk = *(const f32x4*)(p.d_skip + g * 16 + 4 * fq);
    const bf16_t* XB = (const bf16_t*)(p.ws + WS_Z) + 3 * PLANE; bf16_t* YB = (bf16_t*)(p.ws + WS_YB);
    float hre = 0.f, him = 0.f;
    bf16x8 uf = *(const bf16x8*)(XB + (size_t)(row0 + r) * 2048 + g * 16 + 8 * hh);
    u32x2 ue0 = *(const u32x2*)(XB + (size_t)(row0 + fr) * 2048 + g * 16 + 4 * fq), ue1 = *(const u32x2*)(XB + (size_t)(row0 + 16 + fr) * 2048 + g * 16 + 4 * fq);
    for (int ti = 0; ti < ntiles; ++ti) {
        const int R = row0 + 32 * ti;
        float h0r[4] = {0.f, 0.f, 0.f, 0.f}, h0i[4] = {0.f, 0.f, 0.f, 0.f};
        if (sample) {
#pragma unroll
            for (int q = 0; q < 4; ++q) { const size_t o = ((size_t)(seq0 + ti * 4 + q) * 128 + g) * 64 + lane; h0r[q] = p.sre[o]; h0i[q] = p.sim[o]; }
        }
#pragma unroll
        for (int mt = 0; mt < 4; ++mt) {
            f32x16 a = {0.f, 0.f, 0.f, 0.f, 0.f, 0.f, 0.f, 0.f, 0.f, 0.f, 0.f, 0.f, 0.f, 0.f, 0.f, 0.f};
            a = __builtin_amdgcn_mfma_f32_32x32x16_bf16(btf[mt], uf, a, 0, 0, 0);
#pragma unroll
            for (int i = 0; i < 4; ++i) *(LAS f32x4*)(wl + r * S5_ROWB + (32 * mt + 8 * i + 4 * hh) * 4) = (f32x4){a[4 * i], a[4 * i + 1], a[4 * i + 2], a[4 * i + 3]};
        }
        const u32x2 uc0 = ue0, uc1 = ue1;
        if (ti + 1 < ntiles) {
            uf = *(const bf16x8*)(XB + (size_t)(R + 32 + r) * 2048 + g * 16 + 8 * hh);
            ue0 = *(const u32x2*)(XB + (size_t)(R + 32 + fr) * 2048 + g * 16 + 4 * fq); ue1 = *(const u32x2*)(XB + (size_t)(R + 48 + fr) * 2048 + g * 16 + 4 * fq);
        }
        WAVE_ORDER();
        f32x2v buv[32];
#pragma unroll
        for (int t = 0; t < 32; ++t) buv[t] = *(const LAS f32x2v*)(wl + t * S5_ROWB + lane * 8);
#pragma unroll
        for (int t = 0; t < 32; ++t) {
            if (sample && (t & 7) == 0) { hre = h0r[t >> 3]; him = h0i[t >> 3]; }
            const f32x2v bu = buv[t];
            float nre = fmaf(lr, hre, bu.x); nre = fmaf(-li, him, nre);
            float nim = fmaf(lr, him, bu.y); nim = fmaf(li, hre, nim);
            hre = nre; him = nim;
            *(LAS unsigned*)(wl + t * S5_ROWB + lane * 4) = cvt_pk_bf16(hre, him);
            if (sample && (t & 7) == 7) { const size_t o = (size_t)(seq0 + ti * 4 + (t >> 3)) * 8192 + lane; ore[o] = hre; oim[o] = him; }
        }
        WAVE_ORDER();
#pragma unroll
        for (int mt2 = 0; mt2 < 2; ++mt2) {
            f32x4 a2 = (f32x4){0.f, 0.f, 0.f, 0.f};
#pragma unroll
            for (int kt = 0; kt < 4; ++kt) {
                const bf16x8 hf = *(const LAS bf16x8*)(wl + (16 * mt2 + fr) * S5_ROWB + (32 * kt + 8 * fq) * 2);
                a2 = __builtin_amdgcn_mfma_f32_16x16x32_bf16(ctf[kt], hf, a2, 0, 0, 0);
            }
            const u32x2 uc = mt2 ? uc1 : uc0;
            const f32x2v ya = act_pk((f32x2v){a2[0], a2[1]} + (f32x2v){dsk[0], dsk[1]} * (f32x2v){bflo(uc.x), bfhi(uc.x)}, -1.44269504f * 1.5957691216f, -1.44269504f * 0.0713548163f);
            const f32x2v yb2 = act_pk((f32x2v){a2[2], a2[3]} + (f32x2v){dsk[2], dsk[3]} * (f32x2v){bflo(uc.y), bfhi(uc.y)}, -1.44269504f * 1.5957691216f, -1.44269504f * 0.0713548163f);
            u32x2 o; o.x = cvt_pk_bf16(ya.x, ya.y); o.y = cvt_pk_bf16(yb2.x, yb2.y);
            *(u32x2*)(YB + (size_t)(R + 16 * mt2 + fr) * 2048 + g * 16 + 4 * fq) = o;
        }
        WAVE_ORDER();
    }
    if (!sample) { ore[lane] = hre; oim[lane] = him; }
}

__device__ __forceinline__ void phase2(const Params& p, LAS unsigned char* lds) {
    const int tid = threadIdx.x, G = gridDim.x, bid = blockIdx.x, wid = __builtin_amdgcn_readfirstlane(tid >> 6), lane = tid & 63;
    const int nS5 = G / 2;
    LAS unsigned char* wl = lds + wid * S5_WAVE_B;
    if (bid < nS5) {
        if (wid < 4) { for (int t = bid * 4 + wid; t < 512; t += nS5 * 4) s5_task(p, wl, t, lane); }
        else { for (int t = bid * 4 + (wid - 4); t < 1024; t += nS5 * 4) spatial_sample_task(p, t >> 3, t & 7, lane); }
    } else {
        const int nA = G - nS5, ba = bid - nS5;
        if (wid < 4) { for (int t = 512 + ba * 4 + wid; t < 1024; t += nA * 4) s5_task(p, wl, t, lane); }
        __syncthreads();
        spatial_units(p, lds, ba, nA);
    }
}

__global__ void __launch_bounds__(512, 2) hymba_fwd(Params p) {
    extern __shared__ __attribute__((aligned(16))) unsigned char smem[];
    LAS unsigned char* lds = (LAS unsigned char*)smem;
    cg::grid_group grid = cg::this_grid();
    if (p.ws == nullptr) grid.sync();
    if (threadIdx.x < 4) ((LAS unsigned*)(lds + LDS_MAIN))[threadIdx.x] = 0u;
    __syncthreads();
    XcdBarrier bar = xcd_barrier_post((unsigned*)(p.ws + WS_BAR), (volatile LAS unsigned*)(lds + LDS_MAIN));
    const int G = gridDim.x, bid = blockIdx.x;
    unsigned char* ws = p.ws;
    bf16_t* Z = (bf16_t*)(ws + WS_Z);

    for (int rep = 0; rep < REP0; ++rep) phase0(p, lds);
    xcd_barrier(bar);
    {
        pg8::Gemm g{(const bf16_t*)(ws + WS_X16), (const bf16_t*)(ws + WS_WINT), NTOK, 10240, 2048};
        pg8::StaticOrder S; S.init(NTOK, 10240, 2048, G, bid);
        EpiInProj E{Z, (const float*)(ws + WS_RSCALE)};
        pg8::gemm_phase<EpiInProj, pg8::StaticOrder>(lds, g, S, E);
    }
    { const int rem = inproj_rem(G);
      if (rem != 0 && bid >= rem) { transpose_tiles(p, lds, 1280, 2048, bid - rem, G - rem); build_tables(p, (bid - rem) * 512 + (int)threadIdx.x, (G - rem) * 512, G); } }
    xcd_barrier(bar);
    for (int rep = 0; rep < REP2; ++rep) phase2(p, lds);
    xcd_barrier(bar);
    {
        pg8::Gemm g{(const bf16_t*)(ws + WS_YB), (const bf16_t*)(ws + WS_WGLU), NTOK, 2048, 2048};
        pg8::StaticOrder S; S.init(NTOK, 2048, 2048, G, bid, 8);
        if (S.split_active()) S.cnt = (unsigned*)(ws + WS_CNT) + (bid / S.nsplit) * 64;
        EpiGlu E{(const bf16_t*)(ws + WS_YB), Z + 4 * PLANE, p.b_glu, (bf16_t*)(ws + WS_MIX), (float*)(ws + WS_PART), (S.split_active() ? bid / S.nsplit : 0)};
        pg8::gemm_phase<EpiGlu, pg8::StaticOrder>(lds, g, S, E);
        if (S.split_active()) glu_tail_reduce(p, S, G);
    }
    xcd_barrier(bar);
    if (G == 256) {
        {
            pg8::Gemm g{(const bf16_t*)(ws + WS_MIX), (const bf16_t*)(ws + WS_WOUT), NTOK, 2048, 4096};
            OutOrder S{bid};
            EpiOutF E{p.xp, p.out, p.g_final, ws};
            pg8::gemm_phase<EpiOutF, OutOrder>(lds, g, S, E);
        }
        xcd_barrier(bar);
        {
            const int tid = threadIdx.x, wid = tid >> 6, lane = tid & 63, rsub = wid >> 1, half = wid & 1;
            const bf16_t* part = (const bf16_t*)(ws + WS_PART);
            LAS float* sx = (LAS float*)lds;
            for (int r0 = bid * 4; r0 < 1024; r0 += G * 4) {
                const int r = r0 + rsub;
                float* o = p.out + (size_t)(NTOK_P + r) * 2048; const float* xr = p.xs + (size_t)r * 2048;
                const int tub = (r >> 8) * 8 + half * 4;
                f32x4 a[4]; u32x2 q[4][8];
#pragma unroll
                for (int i = 0; i < 4; ++i) {
                    a[i] = __builtin_nontemporal_load((const f32x4*)(xr + (half * 4 + i) * 256 + lane * 4));
                    const bf16_t* pp = part + (size_t)(tub + i) * 65536 + (size_t)(r & 255) * 256 + lane * 4;
#pragma unroll
                    for (int kc = 0; kc < 8; ++kc) q[i][kc] = *(const u32x2*)(pp + (size_t)kc * 32 * 65536);
                }
                float ss = 0.f;
#pragma unroll
                for (int i = 0; i < 4; ++i) {
#pragma unroll
                    for (int kc = 0; kc < 8; ++kc) a[i] += (f32x4){bflo(q[i][kc].x), bfhi(q[i][kc].x), bflo(q[i][kc].y), bfhi(q[i][kc].y)};
                    ss += (a[i][0] * a[i][0] + a[i][1] * a[i][1]) + (a[i][2] * a[i][2] + a[i][3] * a[i][3]);
                }
                ss = wave_sum(ss);
                if (lane == 0) sx[wid] = ss;
                __syncthreads();
                const float rs = rsqrtf((sx[rsub * 2] + sx[rsub * 2 + 1]) * (1.0f / 2048.0f) + EPS);
#pragma unroll
                for (int i = 0; i < 4; ++i) { const f32x4 gf = *(const f32x4*)(p.g_final + (half * 4 + i) * 256 + lane * 4); __builtin_nontemporal_store(a[i] * rs * gf, (f32x4*)(o + (half * 4 + i) * 256 + lane * 4)); }
                __syncthreads();
            }
        }
    }
}

extern "C" void kernel_launch(void* const* d_in, const int* in_sizes, int n_in, void* d_out, int out_size, void* d_ws, size_t ws_size, hipStream_t stream) {
    static int grid_blocks = 0;
    if (grid_blocks == 0) {
        if (n_in != 21 || ws_size < WS_END) { fprintf(stderr, "kernel_launch: unexpected n_in %d / ws_size %zu (need %zu)\n", n_in, ws_size, (size_t)WS_END); grid_blocks = -1; return; }
        int dev = 0, cus = 0, per_cu = 0;
        hipGetDevice(&dev);
        hipDeviceGetAttribute(&cus, hipDeviceAttributeMultiprocessorCount, dev);
        if (hipFuncSetAttribute((const void*)hymba_fwd, hipFuncAttributeMaxDynamicSharedMemorySize, LDS_BYTES) != hipSuccess) { fprintf(stderr, "kernel_launch: hipFuncSetAttribute failed\n"); grid_blocks = -1; return; }
        if (hipOccupancyMaxActiveBlocksPerMultiprocessor(&per_cu, (const void*)hymba_fwd, 512, LDS_BYTES) != hipSuccess || per_cu < 1) { fprintf(stderr, "kernel_launch: occupancy query gave %d\n", per_cu); per_cu = 1; (void)hipGetLastError(); }
        grid_blocks = 256;
        if (cus != 256) fprintf(stderr, "kernel_launch: built for a 256-CU device, found %d CUs\n", cus);
    }
    if (grid_blocks < 0) return;
    if (hipMemsetAsync((char*)d_ws + WS_BAR, 0, 16384, stream) != hipSuccess) { fprintf(stderr, "kernel_launch: memset of the barrier words failed\n"); return; }
    Params p{};
    p.xp = (const float*)d_in[0]; p.xs = (const float*)d_in[1]; p.sre = (const float*)d_in[2]; p.sim = (const float*)d_in[3]; p.g_norm = (const float*)d_in[4];
    p.w_in = (const float*)d_in[5]; p.g_v = (const float*)d_in[6]; p.w_s = (const float*)d_in[7]; p.b_s = (const float*)d_in[8]; p.a_re = (const float*)d_in[9];
    p.a_im = (const float*)d_in[10]; p.log_dt = (const float*)d_in[11]; p.b_re = (const float*)d_in[12]; p.b_im = (const float*)d_in[13]; p.c_re = (const float*)d_in[14];
    p.c_im = (const float*)d_in[15]; p.d_skip = (const float*)d_in[16]; p.w_glu = (const float*)d_in[17]; p.b_glu = (const float*)d_in[18]; p.w_out = (const float*)d_in[19];
    p.g_final = (const float*)d_in[20]; p.out = (float*)d_out; p.ws = (unsigned char*)d_ws;
    void* args[] = {&p};
    hipError_t e = hipLaunchCooperativeKernel((const void*)hymba_fwd, dim3(grid_blocks), dim3(512), args, LDS_BYTES, stream);
    if (e != hipSuccess) fprintf(stderr, "cooperative launch failed: %s (grid %d)\n", hipGetErrorString(e), grid_blocks);
}
```
